# Optimizing an MI355X kernel written in HIP

```python
import jax, jax.numpy as jnp
from jax import lax
import numpy as np

D_MODEL = 2048
BATCH = 2
SEQ = 8192
DEPTH = 4

N_META = 16
D_MIX = D_MODEL
GLA_WIDTH = D_MIX // 2
CONV_WIDTH = D_MIX - GLA_WIDTH
GLA_HEADS = 4
GLA_HEAD_V = GLA_WIDTH // GLA_HEADS
GLA_HEAD_K = GLA_HEAD_V // 2
GLA_KEY = GLA_HEADS * GLA_HEAD_K
GATE_RANK = 16
GATE_TAU = 16.0
CHUNK = 64
CONV_K = 3
EPS = 1e-6

PROJ_SIZES = (GLA_KEY, GLA_KEY, GLA_WIDTH, GLA_WIDTH, GATE_RANK,
              CONV_WIDTH, CONV_WIDTH, CONV_WIDTH, CONV_WIDTH)
D_PROJ = sum(PROJ_SIZES)
SPLIT_POINTS = tuple(int(s) for s in np.cumsum(PROJ_SIZES)[:-1])

kernel_name = 'hymba_gla_shortconv_hybrid'


def rmsnorm(x, gain):
    xf = x.astype(jnp.float32)
    y = xf * lax.rsqrt(jnp.mean(xf * xf, axis=-1, keepdims=True) + EPS)
    return (y * gain.astype(jnp.float32)).astype(x.dtype)


def gla_chunked(q, k, v, log_a):
    bsz, L, H, DK = q.shape
    DV = v.shape[-1]
    pad = (-L) % CHUNK
    padf = lambda t: jnp.pad(t, ((0, 0), (pad, 0), (0, 0), (0, 0)))
    q, k, v, log_a = padf(q), padf(k), padf(v), padf(log_a)
    n_chunks = (L + pad) // CHUNK
    rs = lambda t: t.reshape(bsz, n_chunks, CHUNK, H, t.shape[-1])
    q, k, v, log_a = rs(q), rs(k), rs(v), rs(log_a)
    b = jnp.cumsum(log_a, axis=2)
    b_mid = b[:, :, CHUNK // 2 - 1:CHUNK // 2]
    b_last = b[:, :, -1:]
    q_in = q * jnp.exp(b - b_mid)
    k_in = k * jnp.exp(b_mid - b)
    scores = jnp.einsum('bnihd,bnjhd->bnhij', q_in, k_in)
    causal = jnp.tril(jnp.ones((CHUNK, CHUNK), dtype=bool))
    scores = jnp.where(causal, scores, 0.0)
    o_intra = jnp.einsum('bnhij,bnjhe->bnihe', scores, v)
    k_state = k * jnp.exp(b_last - b)
    upd = jnp.einsum('bnchd,bnche->nbhde', k_state, v)
    decay = jnp.exp(b_last[:, :, 0]).transpose(1, 0, 2, 3)

    def step(state, xs):
        u, a = xs
        return a[..., None] * state + u, state

    s0 = jnp.zeros((bsz, H, DK, DV), dtype=q.dtype)
    _, s_prev = lax.scan(step, s0, (upd, decay))
    o_inter = jnp.einsum('bnchd,nbhde->bnche', q * jnp.exp(b), s_prev)
    o = (o_intra + o_inter).reshape(bsz, n_chunks * CHUNK, H, DV)
    return o[:, pad:]


def causal_dwconv(u, w):
    L = u.shape[1]
    up = jnp.pad(u, ((0, 0), (CONV_K - 1, 0), (0, 0)))
    y = w[0] * up[:, 0:L]
    for i in range(1, CONV_K):
        y = y + w[i] * up[:, i:i + L]
    return y


def hybrid_layer(h, g_pre, w_in, w_gate_up, b_gate, g_gla_out, w_conv, w_out, g_post):
    bsz, L, _ = h.shape
    xn = rmsnorm(h, g_pre)
    p = xn @ w_in
    q, k, v, z_gla, r, hc, gate_b, gate_c, z_conv = jnp.split(p, SPLIT_POINTS, axis=-1)

    log_a = jax.nn.log_sigmoid((r @ w_gate_up + b_gate).astype(jnp.float32)) / GATE_TAU
    heads = lambda t, d: t.reshape(bsz, L, GLA_HEADS, d).astype(jnp.float32)
    o = gla_chunked(heads(q, GLA_HEAD_K) * (GLA_HEAD_K ** -0.5), heads(k, GLA_HEAD_K),
                    heads(v, GLA_HEAD_V), log_a.reshape(bsz, L, GLA_HEADS, GLA_HEAD_K))
    o = rmsnorm(o, g_gla_out).reshape(bsz, L, GLA_WIDTH).astype(h.dtype)
    y_gla = o * jax.nn.silu(z_gla)

    y_conv = gate_b * causal_dwconv(gate_c * hc, w_conv) * jax.nn.silu(z_conv)

    y = jnp.concatenate([y_gla, y_conv], axis=-1) @ w_out
    return h + rmsnorm(y, g_post)


def setup_inputs(seed: int = 0) -> dict:
    key = jax.random.key(seed)
    ks = jax.random.split(key, 11)
    f32 = jnp.float32
    x = jax.random.normal(ks[0], (BATCH, SEQ, D_MODEL), f32)
    meta_tokens = jax.random.normal(ks[1], (N_META, D_MODEL), f32)
    norm_pre = 1.0 + 0.02 * jax.random.normal(ks[2], (DEPTH, D_MODEL), f32)
    w_in = jax.random.normal(ks[3], (DEPTH, D_MODEL, D_PROJ), f32) * D_MODEL ** -0.5
    w_gate_up = jax.random.normal(ks[4], (DEPTH, GATE_RANK, GLA_KEY), f32) * GATE_RANK ** -0.5
    b_gate = 0.1 * jax.random.normal(ks[5], (DEPTH, GLA_KEY), f32)
    gla_out_norm = 1.0 + 0.02 * jax.random.normal(ks[6], (DEPTH, GLA_HEAD_V), f32)
    conv_w = jax.random.normal(ks[7], (DEPTH, CONV_K, CONV_WIDTH), f32) * CONV_K ** -0.5
    w_out = jax.random.normal(ks[8], (DEPTH, D_MIX, D_MODEL), f32) * D_MIX ** -0.5
    norm_post = 1.0 + 0.02 * jax.random.normal(ks[9], (DEPTH, D_MODEL), f32)
    return {'x': x, 'meta_tokens': meta_tokens, 'norm_pre': norm_pre, 'w_in': w_in,
            'w_gate_up': w_gate_up, 'b_gate': b_gate, 'gla_out_norm': gla_out_norm,
            'conv_w': conv_w, 'w_out': w_out, 'norm_post': norm_post}


def reference(x, meta_tokens, norm_pre, w_in, w_gate_up, b_gate, gla_out_norm,
              conv_w, w_out, norm_post):
    bsz = x.shape[0]
    meta = jnp.broadcast_to(meta_tokens.astype(x.dtype)[None], (bsz, N_META, D_MODEL))
    h = jnp.concatenate([meta, x], axis=1)
    for layer in range(DEPTH):
        h = hybrid_layer(h, norm_pre[layer], w_in[layer], w_gate_up[layer], b_gate[layer],
                         gla_out_norm[layer], conv_w[layer], w_out[layer], norm_post[layer])
    return h[:, N_META:]
```

```cpp
#include <hip/hip_runtime.h>
#include <hip/hip_cooperative_groups.h>
#include <cstdio>
#include <cstdint>
namespace cg = cooperative_groups;

#ifndef MK_MULTI
#define MK_MULTI 0
#endif

#define LAS __attribute__((address_space(3)))
typedef unsigned short bf16;
typedef short bf16x8 __attribute__((ext_vector_type(8)));
typedef float f32x4 __attribute__((ext_vector_type(4)));
typedef float f32x16 __attribute__((ext_vector_type(16)));
typedef unsigned u32x4 __attribute__((ext_vector_type(4)));
typedef unsigned u32x2 __attribute__((ext_vector_type(2)));

constexpr int D = 2048, BATCH = 2, SEQ = 8192, DEPTH = 4, NMETA = 16;
constexpr int PADF = 48, LP = 8208, NCH = 129;
constexpr int MROWS = BATCH * LP;
constexpr int MMAIN = 16384;
constexpr int MPAD = MROWS;
constexpr int DPROJ = 7184, NPAD = 7168;
constexpr int PLD = 5120;
constexpr int C_Q = 0, C_K = 512, C_V = 1024, C_ZG = 2048, C_U = 3072, C_G = 4096;
constexpr int PN_FUSE = 12;
constexpr int NSLOT = BATCH * 4 * NCH;
constexpr float EPS = 1e-6f;

constexpr size_t WS_WIN = 0;
constexpr int NWROWS = NPAD + 32;
constexpr size_t SZ_WIN1 = (size_t)NWROWS * D * 2;
constexpr size_t WS_WOUT = WS_WIN + DEPTH * SZ_WIN1;
constexpr size_t SZ_WOUT1 = (size_t)D * D * 2;
constexpr size_t WS_H = WS_WOUT + DEPTH * SZ_WOUT1;
constexpr size_t WS_XN = WS_H + (size_t)MPAD * D * 2;
constexpr size_t WS_P = WS_XN + (size_t)MPAD * D * 2;
constexpr size_t WS_Y = WS_P + (size_t)MPAD * PLD * 2;
constexpr size_t WS_Z = WS_Y + (size_t)MPAD * D * 2;
constexpr size_t WS_ST = WS_Z + (size_t)MPAD * D * 2;
constexpr size_t WS_DEC = WS_ST + (size_t)NSLOT * 32768 * 2;
constexpr size_t WS_R = WS_DEC + (size_t)NSLOT * 128 * 4;
constexpr size_t WS_CTL = WS_R + (size_t)MROWS * 16 * 4;
constexpr size_t CTL_BYTES = 16384;
constexpr size_t WS_END = WS_CTL + CTL_BYTES;

constexpr int NWAVES = 8, NTHR = 512;
constexpr int LDS_BYTES = 131072 + 1024;

typedef float f32x2 __attribute__((ext_vector_type(2)));
typedef __bf16 nbf16x2 __attribute__((ext_vector_type(2)));
__device__ __forceinline__ unsigned pk2(float lo, float hi) { const f32x2 v = {lo, hi}; return __builtin_bit_cast(unsigned, __builtin_convertvector(v, nbf16x2)); }
__device__ __forceinline__ bf16 f2bf(float x) { return (bf16)(pk2(x, 0.f) & 0xffffu); }
__device__ __forceinline__ float bf2f(bf16 u) { return __uint_as_float((unsigned)u << 16); }
__device__ __forceinline__ float bflo(unsigned w) { return __uint_as_float(w << 16); }
__device__ __forceinline__ float bfhi(unsigned w) { return __uint_as_float(w & 0xffff0000u); }
__device__ __forceinline__ float wave_sum(float v) {
#pragma unroll
    for (int o = 1; o < 64; o <<= 1) v += __shfl_xor(v, o);
    return v;
}
__device__ __forceinline__ float silu(float z) { return z * __builtin_amdgcn_rcpf(1.f + __expf(-z)); }
#define LDS_WAIT() asm volatile("s_waitcnt lgkmcnt(0)" ::: "memory")

namespace pg8 {
#define PG8_LAS __attribute__((address_space(3)))
typedef unsigned short bf16_t;
constexpr int BM = 256, BK = 64, HALF = 128, HTB = HALF * BK * 2, STAGE_BYTES = 8 * HTB, NXCD = 8, WGM = 8;

__host__ __device__ __forceinline__ int lds_byte(int r, int c) { const int st = (r >> 4) * 2 + (c >> 5), rr = r & 15, cc = c & 31, ob = rr * 64 + cc * 2; return st * 1024 + (ob ^ (((ob >> 9) & 1) << 5)); }
__host__ __device__ __forceinline__ void stage_rc(int b, int& R, int& C) { const int st = b / 1024, sb = b % 1024, swz = sb ^ (((sb >> 9) & 1) << 5); R = (st >> 1) * 16 + swz / 64; C = (st & 1) * 32 + (swz % 64) / 2; }
__host__ __device__ __forceinline__ int perm32(int rho) { const int n = rho >> 4, i = rho & 15; return 8 * (i >> 2) + 4 * n + (i & 3); }

struct Unit { int pm, pn; };
struct Gemm { const bf16_t* A; const bf16_t* Bt; int M, N, K; };

struct StaticOrder {
    int nM, nN, nwg, G, c;
    __host__ __device__ void init(int M, int N, int G_, int c_) { nM = M / BM; nN = N / BM; nwg = nM * nN; G = G_; c = c_; }
    __host__ __device__ bool next(int i, Unit& u) const {
        const long L = (long)i * G + c; if (L >= nwg) return false;
        int wgid = (int)L; { const int q = nwg / NXCD, r = nwg % NXCD, xcd = wgid % NXCD, off = wgid / NXCD; wgid = (xcd < r ? xcd * (q + 1) : r * (q + 1) + (xcd - r) * q) + off; }
        const int nig = WGM * nN, gid = wgid / nig, fm = gid * WGM, gsz = (nM - fm) < WGM ? (nM - fm) : WGM;
        u.pm = fm + ((wgid % nig) % gsz); u.pn = (wgid % nig) / gsz; return true;
    }
    __device__ __forceinline__ void a_ready(const Unit&) const {}
    __device__ __forceinline__ void done(const Unit&) const {}
};

struct EpiBf16 {
    static constexpr bool PERM = true, AFTER_DRAIN = false;
    bf16_t* O; int ldc; int pn_fuse; const float* rs;
    __device__ __forceinline__ void operator()(const f32x4 (&acc)[2][2][4][2], const Unit& u, int wr, int wc, int fr, int fq) const {
        const int row0 = u.pm * BM + wr * 64 + fr;
        if (u.pn < pn_fuse) {
            const int col0 = u.pn * BM + wc * 32 + 8 * fq;
#pragma unroll
            for (int ai = 0; ai < 2; ++ai)
#pragma unroll
                for (int m = 0; m < 4; ++m) { bf16_t* rowp = O + (size_t)(row0 + ai * HALF + m * 16) * ldc + col0; const float sc = rs ? rs[row0 + ai * HALF + m * 16] : 1.f;
#pragma unroll
                    for (int bj = 0; bj < 2; ++bj) { const f32x4 v0 = acc[ai][bj][m][0] * sc, v1 = acc[ai][bj][m][1] * sc;
                        u32x4 w; w.x = pk2(v0[0], v0[1]); w.y = pk2(v0[2], v0[3]); w.z = pk2(v1[0], v1[1]); w.w = pk2(v1[2], v1[3]);
                        *(u32x4*)(rowp + bj * HALF) = w; } }
        } else {
            const int t = u.pn - pn_fuse; const bool gate = t >= 8;
            const int col0 = pn_fuse * BM + t * HALF + wc * 32 + 8 * fq;
#pragma unroll
            for (int ai = 0; ai < 2; ++ai)
#pragma unroll
                for (int m = 0; m < 4; ++m) { bf16_t* rowp = O + (size_t)(row0 + ai * HALF + m * 16) * ldc + col0; const float sc = rs ? rs[row0 + ai * HALF + m * 16] : 1.f;
                    f32x4 v0 = acc[ai][1][m][0] * sc, v1 = acc[ai][1][m][1] * sc;
                    if (gate) { v0 = (f32x4){silu(v0[0]), silu(v0[1]), silu(v0[2]), silu(v0[3])}; v1 = (f32x4){silu(v1[0]), silu(v1[1]), silu(v1[2]), silu(v1[3])}; }
                    v0 = v0 * (acc[ai][0][m][0] * sc); v1 = v1 * (acc[ai][0][m][1] * sc);
                    u32x4 w; w.x = pk2(v0[0], v0[1]); w.y = pk2(v0[2], v0[3]); w.z = pk2(v1[0], v1[1]); w.w = pk2(v1[2], v1[3]);
                    *(u32x4*)rowp = w; }
        }
    }
};

template <class Epi, class Sched, bool ALIGN_EPI = false, bool SP2 = false>
__device__ __forceinline__ void gemm_phase(PG8_LAS unsigned char* lds, const Gemm g, const Sched& S, const Epi& E) {
    int tid_ = threadIdx.x; asm volatile("" : "+v"(tid_));
    const int tid = tid_, wid = __builtin_amdgcn_readfirstlane(tid >> 6), lane = tid & 63, wr = wid >> 2, wc = wid & 3, fr = lane & 15, fq = lane >> 4;
    const int K = g.K, nt = K / BK;
    unsigned voffA[2], voffB[2];
#pragma unroll
    for (int i = 0; i < 2; ++i) { int R, C; stage_rc(tid * 16 + i * 8192, R, C); const int Rb = Epi::PERM ? ((R & ~31) + perm32(R & 31)) : R;
        voffA[i] = (unsigned)(R * K + C) * 2u; voffB[i] = (unsigned)(Rb * K + C) * 2u; }
    const size_t kstep = (size_t)(BK * 2);
    const size_t hstep = (size_t)HALF * K * 2;
    const size_t tstep = 2 * hstep;
    const unsigned ldsw = (unsigned)wid * 1024u;
    const int aoff = lds_byte(wr * 64 + fr, fq * 8), boff = lds_byte(wc * 32 + fr, fq * 8);
#define PG8_SA(b, h) (((b) * 2 + (h)) * HTB)
#define PG8_SB(b, h) ((4 + (b) * 2 + (h)) * HTB)
#define PG8_STAGE(bufoff, gbase, voff) do { _Pragma("unroll") for (int _i = 0; _i < 2; ++_i) \
        __builtin_amdgcn_global_load_lds((const unsigned*)((const char*)(gbase) + (voff)[_i]), (PG8_LAS unsigned*)(lds + (bufoff) + ldsw + _i * 8192), 16, 0, 0); } while (0)
#define PG8_LDA(dst, b, h) do { _Pragma("unroll") for (int m = 0; m < 4; ++m) _Pragma("unroll") for (int k = 0; k < 2; ++k) dst[m][k] = *(const PG8_LAS bf16x8*)(lds + PG8_SA(b, h) + aoff + m * 2048 + k * 1024); } while (0)
#define PG8_LDB(dst, b, h) do { _Pragma("unroll") for (int n = 0; n < 2; ++n) _Pragma("unroll") for (int k = 0; k < 2; ++k) dst[n][k] = *(const PG8_LAS bf16x8*)(lds + PG8_SB(b, h) + boff + n * 2048 + k * 1024); } while (0)
#define PG8_MMA(ai, bj, At, Bt) do { __builtin_amdgcn_s_setprio(1); _Pragma("unroll") for (int m = 0; m < 4; ++m) _Pragma("unroll") for (int n = 0; n < 2; ++n) _Pragma("unroll") for (int k = 0; k < 2; ++k) \
        acc[ai][bj][m][n] = __builtin_amdgcn_mfma_f32_16x16x32_bf16(Bt[n][k], At[m][k], acc[ai][bj][m][n], 0, 0, 0); __builtin_amdgcn_s_setprio(0); } while (0)
#define PG8_WAIT_V(n) asm volatile("s_waitcnt vmcnt(" #n ")" ::: "memory")
#define PG8_WAIT_L(n) asm volatile("s_waitcnt lgkmcnt(" #n ")" ::: "memory")
#define PG8_BAR __builtin_amdgcn_s_barrier()
#define PG8_SCHED __builtin_amdgcn_sched_barrier(0)
    Unit cur, nxt; int ui = 0;
    if (!S.next(0, cur)) return;
    f32x4 acc[2][2][4][2];
#pragma unroll
    for (int a = 0; a < 2; ++a)
#pragma unroll
        for (int b = 0; b < 2; ++b)
#pragma unroll
            for (int m = 0; m < 4; ++m)
#pragma unroll
                for (int n = 0; n < 2; ++n) acc[a][b][m][n] = (f32x4){0.f, 0.f, 0.f, 0.f};
    bf16x8 At[4][2], B0[2][2], B1[2][2];
    const char* cA = (const char*)g.A + (size_t)cur.pm * tstep; const char* cB = (const char*)g.Bt + (size_t)cur.pn * tstep;
    S.a_ready(cur);
    if constexpr (SP2) {
        PG8_STAGE(PG8_SB(0, 0), cB, voffB); PG8_STAGE(PG8_SB(0, 1), cB + hstep, voffB); PG8_STAGE(PG8_SA(0, 0), cA, voffA); PG8_STAGE(PG8_SA(0, 1), cA + hstep, voffA);
        if (wr == 1) PG8_BAR;
        PG8_WAIT_V(2); PG8_BAR;
        PG8_STAGE(PG8_SB(1, 0), cB + kstep, voffB); PG8_STAGE(PG8_SA(1, 0), cA + kstep, voffA); PG8_STAGE(PG8_SB(1, 1), cB + hstep + kstep, voffB);
        PG8_WAIT_V(6); PG8_BAR;
    } else {
        PG8_STAGE(PG8_SB(0, 0), cB, voffB); PG8_STAGE(PG8_SA(0, 0), cA, voffA); PG8_STAGE(PG8_SB(0, 1), cB + hstep, voffB); PG8_STAGE(PG8_SA(0, 1), cA + hstep, voffA);
        if (wr == 1) PG8_BAR;
        PG8_WAIT_V(4); PG8_BAR;
        PG8_STAGE(PG8_SB(1, 0), cB + kstep, voffB); PG8_STAGE(PG8_SA(1, 0), cA + kstep, voffA); PG8_STAGE(PG8_SB(1, 1), cB + hstep + kstep, voffB);
        PG8_WAIT_V(6); PG8_BAR;
    }
    for (;;) {
        const bool has_next = S.next(ui + 1, nxt);
        const char* nA = has_next ? (const char*)g.A + (size_t)nxt.pm * tstep : cA; const char* nB = has_next ? (const char*)g.Bt + (size_t)nxt.pn * tstep : cB;
        for (int t = 0; t < nt; t += 2) {
            const bool last = (t == nt - 2);
            const char* a1 = cA + (size_t)(t + 1) * kstep;
            const char* a2 = last ? nA : cA + (size_t)(t + 2) * kstep; const char* b2 = last ? nB : cB + (size_t)(t + 2) * kstep;
            const char* a3 = a2 + kstep; const char* b3 = b2 + kstep;
            if (last && has_next) S.a_ready(nxt);
            if constexpr (SP2) {
            PG8_LDB(B0, 0, 0); PG8_LDB(B1, 0, 1); PG8_SCHED; PG8_LDA(At, 0, 0); PG8_STAGE(PG8_SA(1, 1), a1 + hstep, voffA);
            PG8_WAIT_V(8); PG8_WAIT_L(0); PG8_BAR; PG8_MMA(0, 0, At, B0); PG8_MMA(0, 1, At, B1); PG8_BAR; PG8_SCHED;
            PG8_LDA(At, 0, 1); PG8_STAGE(PG8_SB(0, 0), b2, voffB); PG8_STAGE(PG8_SB(0, 1), b2 + hstep, voffB); PG8_STAGE(PG8_SA(0, 0), a2, voffA);
            PG8_WAIT_V(8); PG8_WAIT_L(0); PG8_BAR; PG8_MMA(1, 0, At, B0); PG8_MMA(1, 1, At, B1); PG8_BAR; PG8_SCHED;
            PG8_LDB(B0, 1, 0); PG8_LDB(B1, 1, 1); PG8_SCHED; PG8_LDA(At, 1, 0); PG8_STAGE(PG8_SA(0, 1), a2 + hstep, voffA);
            PG8_WAIT_V(8); PG8_WAIT_L(0); PG8_BAR; PG8_MMA(0, 0, At, B0); PG8_MMA(0, 1, At, B1); PG8_BAR; PG8_SCHED;
            PG8_LDA(At, 1, 1); PG8_STAGE(PG8_SB(1, 0), b3, voffB); PG8_STAGE(PG8_SB(1, 1), b3 + hstep, voffB); PG8_STAGE(PG8_SA(1, 0), a3, voffA);
            PG8_WAIT_V(8); PG8_WAIT_L(0); PG8_BAR; PG8_MMA(1, 0, At, B0); PG8_MMA(1, 1, At, B1); PG8_BAR; PG8_SCHED;
            } else {
            PG8_LDB(B0, 0, 0); PG8_SCHED; PG8_LDA(At, 0, 0); PG8_STAGE(PG8_SA(1, 1), a1 + hstep, voffA);
            PG8_WAIT_L(8); PG8_BAR; PG8_WAIT_L(0); PG8_MMA(0, 0, At, B0); PG8_BAR; PG8_SCHED;
            PG8_LDB(B1, 0, 1); PG8_STAGE(PG8_SB(0, 0), b2, voffB);
            PG8_BAR; PG8_WAIT_L(0); PG8_MMA(0, 1, At, B1); PG8_BAR;
            PG8_LDA(At, 0, 1); PG8_STAGE(PG8_SA(0, 0), a2, voffA);
            PG8_BAR; PG8_WAIT_L(0); PG8_MMA(1, 0, At, B0); PG8_BAR; PG8_SCHED;
            PG8_STAGE(PG8_SB(0, 1), b2 + hstep, voffB);
            PG8_WAIT_V(6); PG8_BAR; PG8_MMA(1, 1, At, B1); PG8_BAR;
            PG8_LDB(B0, 1, 0); PG8_SCHED; PG8_LDA(At, 1, 0); PG8_STAGE(PG8_SA(0, 1), a2 + hstep, voffA);
            PG8_WAIT_L(8); PG8_BAR; PG8_WAIT_L(0); PG8_MMA(0, 0, At, B0); PG8_BAR; PG8_SCHED;
            PG8_LDB(B1, 1, 1); PG8_STAGE(PG8_SB(1, 0), b3, voffB);
            PG8_BAR; PG8_WAIT_L(0); PG8_MMA(0, 1, At, B1); PG8_BAR;
            PG8_LDA(At, 1, 1); PG8_STAGE(PG8_SA(1, 0), a3, voffA);
            PG8_BAR; PG8_WAIT_L(0); PG8_MMA(1, 0, At, B0); PG8_BAR; PG8_SCHED;
            PG8_STAGE(PG8_SB(1, 1), b3 + hstep, voffB);
            PG8_WAIT_V(6); PG8_BAR; PG8_MMA(1, 1, At, B1); PG8_BAR;
            }
        }
        if constexpr (ALIGN_EPI) { if (wr == 0) PG8_BAR; }
        if constexpr (!Epi::AFTER_DRAIN) { E(acc, cur, wr, wc, fr, fq); S.done(cur); }
        if (!has_next) break;
#pragma unroll
        for (int a = 0; a < 2; ++a)
#pragma unroll
            for (int b = 0; b < 2; ++b)
#pragma unroll
                for (int m = 0; m < 4; ++m)
#pragma unroll
                    for (int n = 0; n < 2; ++n) acc[a][b][m][n] = (f32x4){0.f, 0.f, 0.f, 0.f};
        cur = nxt; cA = nA; cB = nB; ++ui;
        if constexpr (ALIGN_EPI) { if (wr == 1) PG8_BAR; }
    }
    PG8_WAIT_V(0);
    if constexpr (!ALIGN_EPI) { if (wr == 0) PG8_BAR; }
    PG8_BAR;
#undef PG8_SA
#undef PG8_SB
#undef PG8_STAGE
#undef PG8_LDA
#undef PG8_LDB
#undef PG8_MMA
#undef PG8_WAIT_V
#undef PG8_WAIT_L
#undef PG8_BAR
#undef PG8_SCHED
}
}

struct Args {
    const float* x; const float* meta; const float* norm_pre; const float* w_in; const float* w_gate_up; const float* b_gate;
    const float* gla_norm; const float* conv_w; const float* w_out; const float* norm_post;
    float* out; unsigned char* ws; int ph_lo, ph_hi;
};

constexpr int T_IIN = (D / 64) * (NPAD / 32), T_IOUT = (D / 64) * (D / 32), T_IL = T_IIN + T_IOUT, T_TOTAL = DEPTH * T_IL;
__device__ __forceinline__ void titem_load(const Args& a, int it, float (&v)[32], int lane) {
    const int l = it / T_IL, r = it % T_IL; const bool win = r < T_IIN; const int item = win ? r : r - T_IIN;
    const int nblk = win ? NPAD / 32 : D / 32, N = win ? DPROJ : D, kb = item / nblk, nb = item % nblk, n0 = 32 * nb;
    const float* W = win ? a.w_in + (size_t)l * D * DPROJ : a.w_out + (size_t)l * D * D;
    int nsrc0 = n0;
    if (win && n0 >= 3072 && n0 < NPAD) { const int q = n0 - 3072, t = q >> 8, half = (q >> 7) & 1, c = q & 127; nsrc0 = (t < 8 ? (half ? 5136 : 3088) + 128 * t : (half ? 6160 : 4112) + 128 * (t - 8)) + c; }
    int ncol = nsrc0 + (lane & 31);
    if (win && n0 >= NPAD) ncol = 3072 + ((lane & 31) < 16 ? (lane & 31) : 15);
    const float* src = W + (size_t)(64 * kb + (lane >> 5)) * N + ncol;
#pragma unroll
    for (int i = 0; i < 32; ++i) v[i] = src[(size_t)(2 * i) * N];
}
__device__ __forceinline__ void titem_store(const Args& a, int it, const float (&v)[32], LAS float* scr, int lane) {
    const int l = it / T_IL, r = it % T_IL; const bool win = r < T_IIN; const int item = win ? r : r - T_IIN;
    const int nblk = win ? NPAD / 32 : D / 32, kb = item / nblk, nb = item % nblk, k0 = 64 * kb, n0 = 32 * nb;
    bf16* WT = win ? (bf16*)(a.ws + WS_WIN + l * SZ_WIN1) : (bf16*)(a.ws + WS_WOUT + l * SZ_WOUT1);
    if (win) { const float* gp = a.norm_pre + (size_t)l * D + k0 + (lane >> 5);
#pragma unroll
        for (int i = 0; i < 32; ++i) scr[(2 * i + (lane >> 5)) * 33 + (lane & 31)] = v[i] * gp[2 * i];
    } else {
#pragma unroll
        for (int i = 0; i < 32; ++i) scr[(2 * i + (lane >> 5)) * 33 + (lane & 31)] = v[i]; }
    LDS_WAIT(); asm volatile("" ::: "memory");
    const int c = lane & 7;
#pragma unroll
    for (int j = 0; j < 4; ++j) { const int nn = (lane >> 3) + 8 * j; const LAS float* sp = scr + (8 * c) * 33 + nn;
        u32x4 o; o.x = pk2(sp[0 * 33], sp[1 * 33]); o.y = pk2(sp[2 * 33], sp[3 * 33]); o.z = pk2(sp[4 * 33], sp[5 * 33]); o.w = pk2(sp[6 * 33], sp[7 * 33]);
        *(u32x4*)(WT + (size_t)(n0 + nn) * D + k0 + 8 * c) = o; }
    LDS_WAIT(); asm volatile("" ::: "memory");
}

constexpr int ROW_ITERS = 9;
static_assert((MROWS + 2047) / 2048 <= ROW_ITERS, "row loop unroll bound");
constexpr int GPOST_OFF = 69632, GPRE_OFF = GPOST_OFF + 8192;
__device__ __forceinline__ void load_gain_lds(LAS unsigned char* lds, int off, const float* g, int tid) { *((LAS f32x4*)(lds + off) + tid) = *((const f32x4*)g + tid); }
__device__ __forceinline__ void xn_tail(const f32x4 (&hv)[8], float s2, bf16* hrow, float* rstd_out, int lane) {
#pragma unroll
    for (int j = 0; j < 4; ++j) { const f32x4 p = hv[2 * j], q = hv[2 * j + 1]; *((u32x4*)hrow + lane + 64 * j) = (u32x4){pk2(p.x, p.y), pk2(p.z, p.w), pk2(q.x, q.y), pk2(q.z, q.w)}; }
    const float rh = rsqrtf(wave_sum(s2) * (1.f / D) + EPS);
    if (lane == 0) *rstd_out = rh;
}

__device__ __forceinline__ void phase_prologue(const Args& a, LAS unsigned char* lds, int G) {
    int tid_ = threadIdx.x; asm volatile("" : "+v"(tid_));
    const int tid = tid_, lane = tid & 63, wave = tid >> 6;
    const int gw = blockIdx.x * NWAVES + wave, NGW = G * NWAVES;
    LAS float* scr = (LAS float*)(lds + wave * 16384);
    {
        float cur[32], nxt[32];
        if (gw < T_TOTAL) titem_load(a, gw, cur, lane);
        for (int it = gw; it < T_TOTAL; it += NGW) {
            const int itn = it + NGW;
            if (itn < T_TOTAL) titem_load(a, itn, nxt, lane);
            titem_store(a, it, cur, scr, lane);
#pragma unroll
            for (int i = 0; i < 32; ++i) cur[i] = nxt[i];
        }
    }
    for (int idx = blockIdx.x * NTHR + tid; idx < DEPTH * 32 * D; idx += G * NTHR) {
        const int l = idx >> 16, e = idx & 65535, j = e >> 11, k = e & 2047;
        const float v = j < 16 ? a.w_in[(size_t)l * D * DPROJ + (size_t)k * DPROJ + 3072 + j] * a.norm_pre[(size_t)l * D + k] : 0.f;
        ((bf16*)(a.ws + WS_WIN + l * SZ_WIN1))[(size_t)(NPAD + j) * D + k] = f2bf(v);
    }
    bf16* H = (bf16*)(a.ws + WS_H); float* RSTD = (float*)(a.ws + WS_XN);
    f32x4 hv[8], hn[8];
    { const int b = gw / LP, tpos = gw % LP; const float* src = tpos < NMETA ? a.meta + (size_t)tpos * D : a.x + ((size_t)b * SEQ + (tpos - NMETA)) * D;
#pragma unroll
      for (int j = 0; j < 8; ++j) hv[j] = *((const f32x4*)src + 2 * (lane + 64 * (j >> 1)) + (j & 1)); }
#pragma unroll
    for (int it_ = 0; it_ < ROW_ITERS; ++it_) { const int m = gw + it_ * NGW; if (m < MROWS) {
        const int mn = m + NGW;
        if (mn < MROWS) { const int b = mn / LP, tpos = mn % LP; const float* src = tpos < NMETA ? a.meta + (size_t)tpos * D : a.x + ((size_t)b * SEQ + (tpos - NMETA)) * D;
#pragma unroll
            for (int j = 0; j < 8; ++j) hn[j] = *((const f32x4*)src + 2 * (lane + 64 * (j >> 1)) + (j & 1)); }
        float s2 = 0.f;
#pragma unroll
        for (int j = 0; j < 8; ++j) s2 += (hv[j].x * hv[j].x + hv[j].y * hv[j].y) + (hv[j].z * hv[j].z + hv[j].w * hv[j].w);
        xn_tail(hv, s2, H + (size_t)m * D, RSTD + m, lane);
#pragma unroll
        for (int j = 0; j < 8; ++j) hv[j] = hn[j];
    } }
}

struct PostRow { u32x4 zr[4]; u32x4 hr[4]; };
__device__ __forceinline__ void post_load(PostRow& p, const bf16* H, const bf16* Z, int m, int lane) {
    const bf16* hrow = H + (size_t)m * D; const bf16* zrow = Z + (size_t)m * D;
#pragma unroll
    for (int j = 0; j < 4; ++j) { p.zr[j] = *((const u32x4*)zrow + lane + 64 * j); p.hr[j] = *((const u32x4*)hrow + lane + 64 * j); }
}
__device__ __forceinline__ void phase_post(const Args& a, int l, LAS unsigned char* lds, int G) {
    int tid_ = threadIdx.x; asm volatile("" : "+v"(tid_));
    const int tid = tid_, lane = tid & 63, wave = tid >> 6;
    const int gw = blockIdx.x * NWAVES + wave, NGW = G * NWAVES;
    bf16* H = (bf16*)(a.ws + WS_H); float* RSTD = (float*)(a.ws + WS_XN); const bf16* Z = (const bf16*)(a.ws + WS_Z);
    const LAS f32x4* gpost = (const LAS f32x4*)(lds + GPOST_OFF);
    const bool lastl = (l == DEPTH - 1);
    PostRow cur, nxt;
    post_load(cur, H, Z, gw, lane);
    load_gain_lds(lds, GPOST_OFF, a.norm_post + (size_t)l * D, tid);
    __syncthreads();
#pragma unroll
    for (int it_ = 0; it_ < ROW_ITERS; ++it_) { const int m = gw + it_ * NGW; if (m < MROWS) {
        const int mn = m + NGW;
        if (mn < MROWS) post_load(nxt, H, Z, mn, lane);
        const int b = m / LP, tpos = m % LP;
        float s = 0.f;
#pragma unroll
        for (int j = 0; j < 4; ++j) { const u32x4 z = cur.zr[j];
            const float a0 = bflo(z.x), a1 = bfhi(z.x), a2 = bflo(z.y), a3 = bfhi(z.y), a4 = bflo(z.z), a5 = bfhi(z.z), a6 = bflo(z.w), a7 = bfhi(z.w);
            s += (a0 * a0 + a1 * a1) + (a2 * a2 + a3 * a3) + (a4 * a4 + a5 * a5) + (a6 * a6 + a7 * a7); }
        const float rz = rsqrtf(wave_sum(s) * (1.f / D) + EPS);
        f32x4 hv[8]; float s2 = 0.f;
#pragma unroll
        for (int j = 0; j < 4; ++j) { const u32x4 hr = cur.hr[j]; hv[2 * j] = (f32x4){bflo(hr.x), bfhi(hr.x), bflo(hr.y), bfhi(hr.y)}; hv[2 * j + 1] = (f32x4){bflo(hr.z), bfhi(hr.z), bflo(hr.w), bfhi(hr.w)}; }
#pragma unroll
        for (int j = 0; j < 4; ++j) { const u32x4 z = cur.zr[j]; const f32x4 g0 = gpost[2 * (lane + 64 * j)], g1 = gpost[2 * (lane + 64 * j) + 1];
            hv[2 * j].x += bflo(z.x) * rz * g0.x; hv[2 * j].y += bfhi(z.x) * rz * g0.y; hv[2 * j].z += bflo(z.y) * rz * g0.z; hv[2 * j].w += bfhi(z.y) * rz * g0.w;
            hv[2 * j + 1].x += bflo(z.z) * rz * g1.x; hv[2 * j + 1].y += bfhi(z.z) * rz * g1.y; hv[2 * j + 1].z += bflo(z.w) * rz * g1.z; hv[2 * j + 1].w += bfhi(z.w) * rz * g1.w;
            s2 += (hv[2 * j].x * hv[2 * j].x + hv[2 * j].y * hv[2 * j].y) + (hv[2 * j].z * hv[2 * j].z + hv[2 * j].w * hv[2 * j].w);
            s2 += (hv[2 * j + 1].x * hv[2 * j + 1].x + hv[2 * j + 1].y * hv[2 * j + 1].y) + (hv[2 * j + 1].z * hv[2 * j + 1].z + hv[2 * j + 1].w * hv[2 * j + 1].w); }
        if (lastl) {
            if (tpos >= NMETA) { float* orow = a.out + ((size_t)b * SEQ + (tpos - NMETA)) * D;
#pragma unroll
                for (int j = 0; j < 8; ++j) { const int e4 = 2 * (lane + 64 * (j >> 1)) + (j & 1); *((f32x4*)orow + e4) = hv[j]; } }
        } else {
            xn_tail(hv, s2, H + (size_t)m * D, RSTD + m, lane);
        }
        if (mn < MROWS) cur = nxt;
    } }
}

__device__ __forceinline__ void r_gemm(const bf16* H, const bf16* WrT, const float* rs, float* R, int G, LAS unsigned char* lds) {
    int tid_ = threadIdx.x; asm volatile("" : "+v"(tid_));
    const int tid = tid_, lane = tid & 63, wave = __builtin_amdgcn_readfirstlane(tid >> 6), fr = lane & 15, fq = lane >> 4;
    constexpr int KS = 2, SLOTS = NWAVES / KS, KSTEPS = (D / 32) / KS, NJOBS = MMAIN / 16, WS_ROW = D + 8;
    const int slot = wave / KS, kpart = wave % KS;
    LAS bf16* wimg = (LAS bf16*)lds; LAS f32x4* part = (LAS f32x4*)(lds + 16 * WS_ROW * 2);
    {
        u32x4 t[8];
#pragma unroll
        for (int i = 0; i < 8; ++i) t[i] = *((const u32x4*)WrT + tid + 512 * i);
#pragma unroll
        for (int i = 0; i < 8; ++i) { const int pc = tid + 512 * i, row = pc >> 8, c8 = pc & 255; *(LAS u32x4*)(wimg + row * WS_ROW + c8 * 8) = t[i]; }
    }
    __syncthreads();
    for (int j0 = 0; j0 < NJOBS; j0 += SLOTS * G) {
        const int job = j0 + slot * G + (int)blockIdx.x; const bool live = job < NJOBS;
        f32x4 acc = (f32x4){0.f, 0.f, 0.f, 0.f};
        if (live) {
            const bf16* ap = H + (size_t)(job * 16 + fr) * D + 8 * fq + kpart * KSTEPS * 32;
            const LAS bf16* bp = wimg + fr * WS_ROW + 8 * fq + kpart * KSTEPS * 32;
#pragma unroll
            for (int kk = 0; kk < KSTEPS; ++kk) { const bf16x8 av = *(const bf16x8*)(ap + 32 * kk), bv = *(const LAS bf16x8*)(bp + 32 * kk); acc = __builtin_amdgcn_mfma_f32_16x16x32_bf16(bv, av, acc, 0, 0, 0); }
            if (kpart != 0) part[wave * 64 + lane] = acc;
        }
        __syncthreads();
        if (live && kpart == 0) { acc += part[(wave + 1) * 64 + lane]; const int m = job * 16 + fr; *(f32x4*)(R + (size_t)m * 16 + 4 * fq) = acc * rs[m]; }
        __syncthreads();
    }
}

template <int KS, bool FUSED>
__device__ __forceinline__ void skinny_gemm(const bf16* A, const bf16* Bt, int N, bf16* O, int ldc, int G, LAS unsigned char* lds, const float* rs, float* Rl) {
    int tid_ = threadIdx.x; asm volatile("" : "+v"(tid_));
    const int tid = tid_, lane = tid & 63, wave = __builtin_amdgcn_readfirstlane(tid >> 6), fr = lane & 15, fq = lane >> 4;
    constexpr int NRG = (MROWS - MMAIN) / 16, NB = FUSED ? 2 : 1, SLOTS = NWAVES / KS, KSTEPS = (D / 32) / KS;
    const int ncg = FUSED ? 96 + 16 * 8 + 1 : N / 16, njobs = NRG * ncg;
    const int slot = wave / KS, kpart = wave % KS;
    LAS f32x4* part = (LAS f32x4*)lds;
    for (int j0 = 0; j0 < njobs; j0 += SLOTS * G) {
        const int job = j0 + slot * G + (int)blockIdx.x; const bool live = job < njobs;
        const int rg = job % NRG, cgp = job / NRG;
        const bool isr = FUSED && cgp == 96 + 16 * 8, fused = FUSED && cgp >= 96 && !isr; const int t = (cgp - 96) >> 3, c16 = (cgp - 96) & 7;
        const int brow0 = FUSED ? (isr ? NPAD : fused ? 3072 + 256 * t + 16 * c16 : 32 * cgp) : 16 * cgp, bstep = fused ? 128 : 16;
        f32x4 acc[NB];
#pragma unroll
        for (int nb = 0; nb < NB; ++nb) acc[nb] = (f32x4){0.f, 0.f, 0.f, 0.f};
        if (live) {
            const bf16* ap = A + (size_t)(rg * 16 + fr) * D + 8 * fq + kpart * KSTEPS * 32;
            const bf16* bp = Bt + (size_t)(brow0 + fr) * D + 8 * fq + kpart * KSTEPS * 32;
#pragma unroll
            for (int kk = 0; kk < KSTEPS; ++kk) { const bf16x8 av = *(const bf16x8*)(ap + 32 * kk);
#pragma unroll
                for (int nb = 0; nb < NB; ++nb) { const bf16x8 bv = *(const bf16x8*)(bp + (size_t)nb * bstep * D + 32 * kk); acc[nb] = __builtin_amdgcn_mfma_f32_16x16x32_bf16(bv, av, acc[nb], 0, 0, 0); } }
            if (kpart != 0) {
#pragma unroll
                for (int nb = 0; nb < NB; ++nb) part[(wave * NB + nb) * 64 + lane] = acc[nb]; }
        }
        __syncthreads();
        if (live && kpart == 0) {
#pragma unroll
            for (int p = 1; p < KS; ++p)
#pragma unroll
                for (int nb = 0; nb < NB; ++nb) acc[nb] += part[((wave + p) * NB + nb) * 64 + lane];
            if (rs) { const float sc = rs[rg * 16 + fr];
#pragma unroll
                for (int nb = 0; nb < NB; ++nb) acc[nb] = acc[nb] * sc; }
            bf16* orow = O + (size_t)(rg * 16 + fr) * ldc + 4 * fq;
            if (isr) *(f32x4*)(Rl + (size_t)(rg * 16 + fr) * 16 + 4 * fq) = acc[0];
            else if (!FUSED) *(u32x2*)(orow + 16 * cgp) = (u32x2){pk2(acc[0][0], acc[0][1]), pk2(acc[0][2], acc[0][3])};
            else if (!fused) {
#pragma unroll
                for (int nb = 0; nb < NB; ++nb) *(u32x2*)(orow + 32 * cgp + nb * 16) = (u32x2){pk2(acc[nb][0], acc[nb][1]), pk2(acc[nb][2], acc[nb][3])};
            } else {
                f32x4 v = acc[NB - 1];
                if (t >= 8) v = (f32x4){silu(v[0]), silu(v[1]), silu(v[2]), silu(v[3])};
                v = v * acc[0];
                *(u32x2*)(orow + C_U + 128 * t + 16 * c16) = (u32x2){pk2(v[0], v[1]), pk2(v[2], v[3])};
            }
        }
        __syncthreads();
    }
}

constexpr int RS_OFF = 0;
constexpr int TOT_OFF = 4096;
constexpr int SC_OFF = 6144;
constexpr int Q1_OFF = 15360;
constexpr int Q2_OFF = Q1_OFF + 17408;
constexpr int K1_OFF = Q2_OFF + 17408;
constexpr int VT_OFF = K1_OFF + 17408;
constexpr int O_OFF = Q1_OFF;
constexpr int QS = 136, VS = 72, OS = 260;

__device__ __forceinline__ int crow(int reg, int h) { return (reg & 3) + 8 * (reg >> 2) + 4 * h; }
#define MFMA32(a, b, c) __builtin_amdgcn_mfma_f32_32x32x16_bf16((a), (b), (c), 0, 0, 0)

__device__ __forceinline__ void gla_decay(LAS unsigned char* lds, const f32x4 rr, const float (&wgr)[16], float bgv, int n, int tid,
                                          float (&bl)[16], float& bmid, float& blast) {
    LAS float* rs = (LAS float*)(lds + RS_OFF); LAS float* tot = (LAS float*)(lds + TOT_OFF);
    const int d = tid & 127, qr = tid >> 7;
    if (tid < 256) *((LAS f32x4*)rs + tid) = rr;
    __syncthreads();
    float acc = 0.f;
#pragma unroll
    for (int ii = 0; ii < 16; ++ii) { const int i = qr * 16 + ii; const LAS f32x4* rp = (const LAS f32x4*)(rs + i * 16);
        const f32x4 r0 = rp[0], r1 = rp[1], r2 = rp[2], r3 = rp[3];
        float x = bgv;
        x += r0.x * wgr[0] + r0.y * wgr[1] + r0.z * wgr[2] + r0.w * wgr[3];
        x += r1.x * wgr[4] + r1.y * wgr[5] + r1.z * wgr[6] + r1.w * wgr[7];
        x += r2.x * wgr[8] + r2.y * wgr[9] + r2.z * wgr[10] + r2.w * wgr[11];
        x += r3.x * wgr[12] + r3.y * wgr[13] + r3.z * wgr[14] + r3.w * wgr[15];
        float la = (fminf(x, 0.f) - __logf(1.f + __expf(-fabsf(x)))) * (1.f / 16.f);
        if (n == 0 && i < PADF) la = 0.f;
        acc += la; bl[ii] = acc; }
    tot[qr * 128 + d] = acc;
    __syncthreads();
    const float t0 = tot[d], t1 = tot[128 + d], t2 = tot[256 + d], t3 = tot[384 + d];
    const float off = (qr > 0 ? t0 : 0.f) + (qr > 1 ? t1 : 0.f) + (qr > 2 ? t2 : 0.f);
#pragma unroll
    for (int ii = 0; ii < 16; ++ii) bl[ii] += off;
    bmid = t0 + t1; blast = (t0 + t1) + (t2 + t3);
}
__device__ __forceinline__ void gate_weights(const Args& a, int l, int h, int d, float (&wgr)[16], float& bgv) {
    const float* wg = a.w_gate_up + (size_t)l * 16 * 512; const float* bg = a.b_gate + (size_t)l * 512;
#pragma unroll
    for (int jj = 0; jj < 16; ++jj) wgr[jj] = wg[jj * 512 + h * 128 + d];
    bgv = bg[h * 128 + d];
}

constexpr int VRP = 544;
__device__ __forceinline__ void vT_load(u32x4 (&raw)[4], const bf16* Prow0, int h, int n, int tid) {
#pragma unroll
    for (int it = 0; it < 4; ++it) { const int pc = tid + 512 * it, row = pc >> 5, ch = pc & 31; raw[it] = *(const u32x4*)(Prow0 + (size_t)row * PLD + C_V + h * 256 + ch * 8);
        if (n == 0 && row < PADF) raw[it] = (u32x4){0u, 0u, 0u, 0u}; }
}
__device__ __forceinline__ void vT_store(LAS unsigned char* lds, const u32x4 (&rawv)[4], int tid) {
#pragma unroll
    for (int it = 0; it < 4; ++it) { const int pc = tid + 512 * it, row = pc >> 5, ch = pc & 31; *(LAS u32x4*)(lds + VT_OFF + row * VRP + ch * 16) = rawv[it]; }
}
typedef short s16x4 __attribute__((ext_vector_type(4)));
__device__ __forceinline__ void vT_frags(bf16x8 (&b)[4], LAS unsigned char* lds, int c, int lane) {
    const int hh = lane >> 5, blk = (lane >> 4) & 1, q = (lane & 15) >> 2, p = lane & 3;
    const unsigned addr = (unsigned)(uintptr_t)(lds + VT_OFF) + (unsigned)((8 * hh + q) * VRP + 16 * (4 * c + 2 * blk + (p >> 1)) + 8 * (p & 1));
    s16x4 r0, r1, r2, r3, r4, r5, r6, r7;
    asm volatile("ds_read_b64_tr_b16 %0, %8\n\tds_read_b64_tr_b16 %1, %8 offset:2176\n\tds_read_b64_tr_b16 %2, %8 offset:8704\n\tds_read_b64_tr_b16 %3, %8 offset:10880\n\t"
                 "ds_read_b64_tr_b16 %4, %8 offset:17408\n\tds_read_b64_tr_b16 %5, %8 offset:19584\n\tds_read_b64_tr_b16 %6, %8 offset:26112\n\tds_read_b64_tr_b16 %7, %8 offset:28288\n\ts_waitcnt lgkmcnt(0)"
                 : "=&v"(r0), "=&v"(r1), "=&v"(r2), "=&v"(r3), "=&v"(r4), "=&v"(r5), "=&v"(r6), "=&v"(r7) : "v"(addr) : "memory");
    b[0] = __builtin_shufflevector(r0, r1, 0, 1, 2, 3, 4, 5, 6, 7); b[1] = __builtin_shufflevector(r2, r3, 0, 1, 2, 3, 4, 5, 6, 7);
    b[2] = __builtin_shufflevector(r4, r5, 0, 1, 2, 3, 4, 5, 6, 7); b[3] = __builtin_shufflevector(r6, r7, 0, 1, 2, 3, 4, 5, 6, 7);
}
static_assert(4 * VRP == 2176 && 16 * VRP == 8704 && 20 * VRP == 10880 && 32 * VRP == 17408 && 36 * VRP == 19584 && 48 * VRP == 26112 && 52 * VRP == 28288, "tr-read offsets");

struct G1Pre { bf16 kraw[16]; u32x4 vraw[4]; f32x4 rr; };
__device__ __forceinline__ void g1_load(G1Pre& p, const Args& a, int item, int tid, int wave, int lane) {
    const int n = item >> 3, bh = item & 7, b = bh >> 2, h = bh & 3, d = tid & 127, qr = tid >> 7;
    const long crow0 = (long)b * LP + n * 64 - PADF;
    const bf16* Prow0 = (const bf16*)(a.ws + WS_P) + crow0 * PLD;
    const bf16* kp = Prow0 + (size_t)(qr * 16) * PLD + C_K + h * 128 + d;
#pragma unroll
    for (int ii = 0; ii < 16; ++ii) { p.kraw[ii] = kp[(size_t)ii * PLD]; if (n == 0 && qr * 16 + ii < PADF) p.kraw[ii] = 0; }
    vT_load(p.vraw, Prow0, h, n, tid);
    p.rr = (f32x4){0.f, 0.f, 0.f, 0.f};
    if (tid < 256) p.rr = *((const f32x4*)((const float*)(a.ws + WS_R) + crow0 * 16) + tid);
}
__device__ __forceinline__ void phase_gla1(const Args& a, int l, LAS unsigned char* lds, int G) {
    int tid_ = threadIdx.x; asm volatile("" : "+v"(tid_));
    const int tid = tid_, lane = tid & 63, wave = __builtin_amdgcn_readfirstlane(tid >> 6), r = lane & 31, hh = lane >> 5;
    bf16* ST = (bf16*)(a.ws + WS_ST); float* DEC = (float*)(a.ws + WS_DEC);
    const int d = tid & 127, qr = tid >> 7;
    constexpr int NITEM = BATCH * 4 * (NCH - 1);
    if ((int)blockIdx.x >= NITEM) return;
    float wgr[16], bgv; gate_weights(a, l, (int)blockIdx.x & 3, d, wgr, bgv);
    G1Pre cur, nxt;
    g1_load(cur, a, (int)blockIdx.x, tid, wave, lane);
    for (int item = blockIdx.x; item < NITEM; item += G) {
        const int n = item >> 3, bh = item & 7, b = bh >> 2, h = bh & 3;
        const int slot = (b * 4 + h) * NCH + n;
        float bl[16], bmid, blast;
        gla_decay(lds, cur.rr, wgr, bgv, n, tid, bl, bmid, blast);
        {
            LAS bf16* kst = (LAS bf16*)(lds + Q1_OFF);
            unsigned pk[8];
#pragma unroll
            for (int ii = 0; ii < 16; ii += 2) { const float k0 = bf2f(cur.kraw[ii]) * __expf(blast - bl[ii]), k1 = bf2f(cur.kraw[ii + 1]) * __expf(blast - bl[ii + 1]); pk[ii >> 1] = pk2(k0, k1); }
            LAS u32x4* dst = (LAS u32x4*)(kst + d * VS + qr * 16);
            dst[0] = (u32x4){pk[0], pk[1], pk[2], pk[3]}; dst[1] = (u32x4){pk[4], pk[5], pk[6], pk[7]};
        }
        vT_store(lds, cur.vraw, tid);
        if (qr == 0) DEC[(size_t)slot * 128 + d] = __expf(blast);
        __syncthreads();
        if (item + G < NITEM) g1_load(nxt, a, item + G, tid, wave, lane);
        f32x16 acc[4];
#pragma unroll
        for (int db = 0; db < 4; ++db)
#pragma unroll
            for (int i = 0; i < 16; ++i) acc[db][i] = 0.f;
        const LAS bf16* kst = (const LAS bf16*)(lds + Q1_OFF);
        bf16x8 vfr[4]; vT_frags(vfr, lds, wave, lane);
#pragma unroll
        for (int s = 0; s < 4; ++s) { const bf16x8 bfr = vfr[s];
#pragma unroll
            for (int db = 0; db < 4; ++db) { const bf16x8 afr = *(const LAS bf16x8*)(kst + (32 * db + r) * VS + 16 * s + 8 * hh); acc[db] = MFMA32(afr, bfr, acc[db]); } }
        bf16* st = ST + (size_t)slot * 32768 + (32 * wave + r) * 128 + 8 * hh;
#pragma unroll
        for (int db = 0; db < 4; ++db)
#pragma unroll
            for (int g = 0; g < 4; g += 2) {
                const unsigned kx = pk2(acc[db][4 * g], acc[db][4 * g + 1]), ky = pk2(acc[db][4 * g + 2], acc[db][4 * g + 3]);
                const unsigned k1x = pk2(acc[db][4 * g + 4], acc[db][4 * g + 5]), k1y = pk2(acc[db][4 * g + 6], acc[db][4 * g + 7]);
                const u32x2 sx = __builtin_amdgcn_permlane32_swap(kx, k1x, false, false), sy = __builtin_amdgcn_permlane32_swap(ky, k1y, false, false);
                *(u32x4*)(st + 32 * db + 8 * g) = (u32x4){sx.x, sy.x, sx.y, sy.y}; }
        __syncthreads();
        cur = nxt;
    }
}

__device__ __forceinline__ void unpack8(const u32x4 v, float (&o)[8]) { o[0] = bflo(v.x); o[1] = bfhi(v.x); o[2] = bflo(v.y); o[3] = bfhi(v.y); o[4] = bflo(v.z); o[5] = bfhi(v.z); o[6] = bflo(v.w); o[7] = bfhi(v.w); }
__device__ __forceinline__ void phase_conv(const Args& a, int l, int G, int cb0) {
    const bf16* P = (const bf16*)(a.ws + WS_P); bf16* Y = (bf16*)(a.ws + WS_Y);
    const float* cw = a.conv_w + (size_t)l * 3 * 1024;
    constexpr int RB = 9, NRB = MROWS / RB;
    const int nthr = (G - cb0) * NTHR;
    int tid_ = threadIdx.x; asm volatile("" : "+v"(tid_));
    for (int idx = ((int)blockIdx.x - cb0) * NTHR + tid_; idx < NRB * 128; idx += nthr) {
        const int rb = idx >> 7, c8 = idx & 127, c0 = c8 * 8;
        const int m0 = rb * RB, tpos0 = m0 % LP;
        bf16* yp = Y + (size_t)m0 * D + 1024 + c0;
        float w0[8], w1[8], w2[8];
#pragma unroll
        for (int t = 0; t < 8; ++t) { w0[t] = cw[c0 + t]; w1[t] = cw[1024 + c0 + t]; w2[t] = cw[2048 + c0 + t]; }
        const bf16* pr = P + (size_t)m0 * PLD + c0;
        u32x4 ur[RB + 2], gr[RB];
        ur[0] = *(const u32x4*)(pr - (size_t)2 * PLD + C_U); ur[1] = *(const u32x4*)(pr - (size_t)PLD + C_U);
#pragma unroll
        for (int i = 0; i < RB; ++i) { ur[2 + i] = *(const u32x4*)(pr + (size_t)i * PLD + C_U); gr[i] = *(const u32x4*)(pr + (size_t)i * PLD + C_G); }
        float um2[8], um1[8];
        unpack8(ur[0], um2); unpack8(ur[1], um1);
        if (tpos0 == 0) {
#pragma unroll
            for (int t = 0; t < 8; ++t) { um1[t] = 0.f; um2[t] = 0.f; } }
#pragma unroll
        for (int i = 0; i < RB; ++i) {
            float u[8], g[8], y[8];
            unpack8(ur[2 + i], u); unpack8(gr[i], g);
#pragma unroll
            for (int t = 0; t < 8; ++t) { y[t] = g[t] * (w0[t] * um2[t] + w1[t] * um1[t] + w2[t] * u[t]); um2[t] = um1[t]; um1[t] = u[t]; }
            u32x4 o; o.x = pk2(y[0], y[1]); o.y = pk2(y[2], y[3]); o.z = pk2(y[4], y[5]); o.w = pk2(y[6], y[7]);
            *(u32x4*)(yp + (size_t)i * D) = o;
        }
    }
}

__device__ __forceinline__ void phase_scan(const Args& a, int G) {
    bf16* ST = (bf16*)(a.ws + WS_ST); const float* DEC = (const float*)(a.ws + WS_DEC);
    const int nthr = G * NTHR;
    int tid_ = threadIdx.x; asm volatile("" : "+v"(tid_));
    for (int idx = blockIdx.x * NTHR + tid_; idx < 8 * 256 * 64; idx += nthr) {
        const int dp = idx & 63, e = (idx >> 6) & 255, bh = idx >> 14;
        unsigned* sp = (unsigned*)(ST + (size_t)bh * NCH * 32768 + e * 128 + 2 * dp);
        const float* dp_ = DEC + (size_t)bh * NCH * 128 + 2 * dp;
        float s0 = 0.f, s1 = 0.f;
        for (int n0 = 0; n0 < NCH - 1; n0 += 8) {
            unsigned u[8]; float a0[8], a1[8];
#pragma unroll
            for (int k = 0; k < 8; ++k) { u[k] = sp[(size_t)(n0 + k) * 16384]; a0[k] = dp_[(n0 + k) * 128]; a1[k] = dp_[(n0 + k) * 128 + 1]; }
#pragma unroll
            for (int k = 0; k < 8; ++k) { sp[(size_t)(n0 + k) * 16384] = pk2(s0, s1); s0 = a0[k] * s0 + bflo(u[k]); s1 = a1[k] * s1 + bfhi(u[k]); }
        }
        sp[(size_t)(NCH - 1) * 16384] = pk2(s0, s1);
    }
}

struct G2Pre { bf16x8 sb[8]; unsigned qk[16]; u32x4 vraw[4], zraw[4]; f32x4 rr; };
__device__ __forceinline__ void g2_load(G2Pre& p, const Args& a, int item, int tid, int wave, int lane) {
    const int n = item >> 3, bh = item & 7, b = bh >> 2, h = bh & 3, d = tid & 127, qr = tid >> 7, r = lane & 31, hh = lane >> 5;
    const int slot = (b * 4 + h) * NCH + n;
    const long crow0 = (long)b * LP + n * 64 - PADF;
    const bf16* Prow0 = (const bf16*)(a.ws + WS_P) + crow0 * PLD;
    if (n != 0) { const bf16* stp = (const bf16*)(a.ws + WS_ST) + (size_t)slot * 32768 + (32 * wave + r) * 128 + 8 * hh;
#pragma unroll
        for (int s = 0; s < 8; ++s) p.sb[s] = *(const bf16x8*)(stp + 16 * s); }
    else {
#pragma unroll
        for (int s = 0; s < 8; ++s) p.sb[s] = (bf16x8){0, 0, 0, 0, 0, 0, 0, 0}; }
    const bf16* qp = Prow0 + (size_t)(qr * 16) * PLD + C_Q + h * 128 + d;
#pragma unroll
    for (int ii = 0; ii < 16; ++ii) { p.qk[ii] = (unsigned)qp[(size_t)ii * PLD] | ((unsigned)qp[(size_t)ii * PLD + C_K] << 16); if (n == 0 && qr * 16 + ii < PADF) p.qk[ii] = 0u; }
    vT_load(p.vraw, Prow0, h, n, tid);
    const bf16* zp = Prow0 + (size_t)(tid >> 3) * PLD + C_ZG + h * 256 + (tid & 7) * 32;
#pragma unroll
    for (int j = 0; j < 4; ++j) p.zraw[j] = *(const u32x4*)(zp + 8 * j);
    p.rr = (f32x4){0.f, 0.f, 0.f, 0.f};
    if (tid < 256) p.rr = *((const f32x4*)((const float*)(a.ws + WS_R) + crow0 * 16) + tid);
}
__device__ __forceinline__ void gla2_items(const Args& a, int l, LAS unsigned char* lds, int item0, int item1, int istride) {
    int tid_ = threadIdx.x; asm volatile("" : "+v"(tid_));
    const int tid = tid_, lane = tid & 63, wave = __builtin_amdgcn_readfirstlane(tid >> 6), r = lane & 31, hh = lane >> 5;
    bf16* Y = (bf16*)(a.ws + WS_Y);
    const float* gno = a.gla_norm + (size_t)l * 256;
    const float qscale = 0.08838834764831845f;
    const int d = tid & 127, qr = tid >> 7;
    if (item0 >= item1) return;
    float wgr[16], bgv; gate_weights(a, l, item0 & 3, d, wgr, bgv);
    G2Pre cur, nxt;
    g2_load(cur, a, item0, tid, wave, lane);
    for (int item = item0; item < item1; item += istride) {
        const int n = item >> 3, bh = item & 7, b = bh >> 2, h = bh & 3;
        const long crow0 = (long)b * LP + n * 64 - PADF;
        float bl[16], bmid, blast;
        gla_decay(lds, cur.rr, wgr, bgv, n, tid, bl, bmid, blast);
        {
            LAS bf16* Q1 = (LAS bf16*)(lds + Q1_OFF); LAS bf16* Q2 = (LAS bf16*)(lds + Q2_OFF); LAS bf16* K1 = (LAS bf16*)(lds + K1_OFF);
            const float embm = __expf(-bmid), ebm = __expf(bmid);
#pragma unroll
            for (int ii = 0; ii < 16; ++ii) { const int i = qr * 16 + ii; const float e2 = __expf(bl[ii]);
                const float q = bflo(cur.qk[ii]) * qscale * e2, k = bfhi(cur.qk[ii]) * ebm * __builtin_amdgcn_rcpf(e2);
                Q2[i * QS + d] = f2bf(q); Q1[i * QS + d] = f2bf(q * embm); K1[i * QS + d] = f2bf(k); }
        }
        vT_store(lds, cur.vraw, tid);
        __syncthreads();
        if (item + istride < item1) g2_load(nxt, a, item + istride, tid, wave, lane);
        const LAS bf16* Q1 = (const LAS bf16*)(lds + Q1_OFF); const LAS bf16* Q2 = (const LAS bf16*)(lds + Q2_OFF); const LAS bf16* K1 = (const LAS bf16*)(lds + K1_OFF);
        LAS bf16* SC = (LAS bf16*)(lds + SC_OFF);
        if (wave < 3) {
            const int jt = wave == 2 ? 1 : 0, it = wave == 0 ? 0 : 1;
            f32x16 sc;
#pragma unroll
            for (int i = 0; i < 16; ++i) sc[i] = 0.f;
#pragma unroll
            for (int s = 0; s < 8; ++s) { const bf16x8 af = *(const LAS bf16x8*)(K1 + (32 * jt + r) * QS + 16 * s + 8 * hh), bf = *(const LAS bf16x8*)(Q1 + (32 * it + r) * QS + 16 * s + 8 * hh); sc = MFMA32(af, bf, sc); }
            const int i = 32 * it + r;
#pragma unroll
            for (int g = 0; g < 4; ++g) { const int j0 = 32 * jt + 8 * g + 4 * hh;
                const float v0 = (j0 + 0 <= i) ? sc[4 * g] : 0.f, v1 = (j0 + 1 <= i) ? sc[4 * g + 1] : 0.f, v2 = (j0 + 2 <= i) ? sc[4 * g + 2] : 0.f, v3 = (j0 + 3 <= i) ? sc[4 * g + 3] : 0.f;
                *(LAS u32x2*)(SC + i * VS + j0) = (u32x2){pk2(v0, v1), pk2(v2, v3)}; }
        }
        f32x16 acc[2];
#pragma unroll
        for (int mi = 0; mi < 2; ++mi)
#pragma unroll
            for (int i = 0; i < 16; ++i) acc[mi][i] = 0.f;
#pragma unroll
        for (int s = 0; s < 8; ++s)
#pragma unroll
            for (int mi = 0; mi < 2; ++mi) { const bf16x8 af = *(const LAS bf16x8*)(Q2 + (32 * mi + r) * QS + 16 * s + 8 * hh); acc[mi] = MFMA32(af, cur.sb[s], acc[mi]); }
        __syncthreads();
        bf16x8 vfr[4]; vT_frags(vfr, lds, wave, lane);
#pragma unroll
        for (int s = 0; s < 4; ++s) { const bf16x8 bf = vfr[s];
            if (s < 2) { const bf16x8 af = *(const LAS bf16x8*)(SC + r * VS + 16 * s + 8 * hh); acc[0] = MFMA32(af, bf, acc[0]); }
            const bf16x8 af1 = *(const LAS bf16x8*)(SC + (32 + r) * VS + 16 * s + 8 * hh); acc[1] = MFMA32(af1, bf, acc[1]); }
        __syncthreads();
        LAS float* O = (LAS float*)(lds + O_OFF);
#pragma unroll
        for (int mi = 0; mi < 2; ++mi)
#pragma unroll
            for (int g = 0; g < 16; ++g) O[(32 * mi + crow(g, hh)) * OS + 32 * wave + r] = acc[mi][g];
        __syncthreads();
        {
            const int i = tid >> 3, seg = tid & 7;
            const LAS f32x4* op = (const LAS f32x4*)(O + i * OS + seg * 32);
            f32x4 o[8]; float s = 0.f;
#pragma unroll
            for (int j = 0; j < 8; ++j) { o[j] = op[j]; s += (o[j].x * o[j].x + o[j].y * o[j].y) + (o[j].z * o[j].z + o[j].w * o[j].w); }
            s += __shfl_xor(s, 1); s += __shfl_xor(s, 2); s += __shfl_xor(s, 4);
            const float rstd = rsqrtf(s * (1.f / 256.f) + EPS);
            bf16* yp = Y + (crow0 + i) * D + h * 256 + seg * 32;
            if (n != 0 || i >= PADF)
#pragma unroll
            for (int j = 0; j < 4; ++j) { const u32x4 z = cur.zraw[j]; const f32x4 g0 = *(const f32x4*)(gno + seg * 32 + 8 * j), g1 = *(const f32x4*)(gno + seg * 32 + 8 * j + 4);
                const f32x4 p = o[2 * j], q = o[2 * j + 1];
                u32x4 w;
                w.x = pk2(p.x * rstd * g0.x * silu(bflo(z.x)), p.y * rstd * g0.y * silu(bfhi(z.x)));
                w.y = pk2(p.z * rstd * g0.z * silu(bflo(z.y)), p.w * rstd * g0.w * silu(bfhi(z.y)));
                w.z = pk2(q.x * rstd * g1.x * silu(bflo(z.z)), q.y * rstd * g1.y * silu(bfhi(z.z)));
                w.w = pk2(q.z * rstd * g1.z * silu(bflo(z.w)), q.w * rstd * g1.w * silu(bfhi(z.w)));
                *(u32x4*)(yp + 8 * j) = w; }
        }
        __syncthreads();
        cur = nxt;
    }
}

__device__ __forceinline__ void phase_gla2(const Args& a, int l, LAS unsigned char* lds, int G) { gla2_items(a, l, lds, 8 + (int)blockIdx.x, BATCH * 4 * NCH, G); }

#define XB_TMO      128
#define XB_XCNT(j)  (256  + 64 * (j))
#define XB_XSUB(j)  (1280 + 64 * (j))
#define XB_XGEN(j)  (2304 + 64 * (j))
#define XB_TOP      3328
#define XB_TOPGEN   3392
#define XCD_BAR_WORDS 3456
#define XB_SPIN_CAP (1u << 18)
__device__ __forceinline__ unsigned xb_ld(unsigned* p)              { return __hip_atomic_load(p, __ATOMIC_RELAXED, __HIP_MEMORY_SCOPE_AGENT); }
__device__ __forceinline__ unsigned xb_add(unsigned* p, unsigned v) { return __hip_atomic_fetch_add(p, v, __ATOMIC_RELAXED, __HIP_MEMORY_SCOPE_AGENT); }
__device__ __forceinline__ unsigned xb_xcc_id() { return (unsigned)__builtin_amdgcn_s_getreg((3 << 11) | 20) & 0xFu; }
#define XB_SPIN(cond, bar) do { unsigned _sp = 0; while (cond) { __builtin_amdgcn_s_sleep(1); \
    if ((++_sp & 255u) == 0u) { if (xb_ld(&(bar)[XB_TMO])) break; if (_sp > XB_SPIN_CAP) { atomicAdd(&(bar)[XB_TMO], 1u); break; } } } } while (0)
struct XcdBarrier { unsigned* bar; unsigned x; volatile LAS unsigned* st; };
__device__ __forceinline__ XcdBarrier xcd_barrier_post(unsigned* bar, volatile LAS unsigned* st) {
    XcdBarrier b; b.bar = bar; b.x = xb_xcc_id(); b.st = st;
    if (threadIdx.x == 0) (void)xb_add(&bar[XB_XCNT(b.x)], 1u);
    return b;
}
__device__ __forceinline__ void xcd_barrier_complete(unsigned* bar, unsigned x, unsigned& nloc, unsigned& nx) {
    const unsigned G = gridDim.x * gridDim.y * gridDim.z;
    unsigned sum, cnt, mine, sp = 0u;
    for (;;) {
        sum = 0u; cnt = 0u; mine = 0u;
#pragma unroll
        for (unsigned j = 0; j < 16; ++j) { const unsigned c = xb_ld(&bar[XB_XCNT(j)]); sum += c; cnt += (c > 0u) ? 1u : 0u; mine = (j == x) ? c : mine; }
        if (sum == G) break;
        __builtin_amdgcn_s_sleep(1);
        if ((++sp & 255u) == 0u) { if (xb_ld(&bar[XB_TMO])) break; if (sp > XB_SPIN_CAP) { atomicAdd(&bar[XB_TMO], 1u); break; } }
    }
    nloc = mine > 0u ? mine : 1u; nx = cnt > 0u ? cnt : 1u;
}
__device__ __forceinline__ void xcd_barrier(const XcdBarrier& b) {
    asm volatile("s_waitcnt vmcnt(0)" ::: "memory");
    __syncthreads();
    if (threadIdx.x == 0) {
        unsigned* bar = b.bar;
        __builtin_amdgcn_s_waitcnt(0);
        unsigned nloc = b.st[0], nx = b.st[1];
        if (nloc == 0u) { xcd_barrier_complete(bar, b.x, nloc, nx); b.st[0] = nloc; b.st[1] = nx; }
        const unsigned old = xb_add(&bar[XB_XSUB(b.x)], 1u);
        const unsigned gen = old / nloc;
        if (old + 1u == (gen + 1u) * nloc) {
            __builtin_amdgcn_fence(__ATOMIC_RELEASE, "agent");
            asm volatile("s_waitcnt vmcnt(0)" ::: "memory");
            const unsigned og = xb_add(&bar[XB_TOP], 1u);
            const unsigned tg = og / nx;
            if (og + 1u == (tg + 1u) * nx) xb_add(&bar[XB_TOPGEN], 1u);
            else XB_SPIN(xb_ld(&bar[XB_TOPGEN]) == tg, bar);
            __builtin_amdgcn_fence(__ATOMIC_ACQUIRE, "agent");
            xb_add(&bar[XB_XGEN(b.x)], 1u);
            asm volatile("s_waitcnt vmcnt(0)" ::: "memory");
        } else {
            XB_SPIN(xb_ld(&bar[XB_XGEN(b.x)]) == gen, bar);
            __builtin_amdgcn_fence(__ATOMIC_ACQUIRE, "agent");
            asm volatile("s_waitcnt vmcnt(0)" ::: "memory");
        }
    }
    __syncthreads();
}

constexpr int NPHASE = 1 + 6 * DEPTH;
__global__ void __launch_bounds__(NTHR, 2) hymba_fwd(Args a) {
    extern __shared__ __attribute__((aligned(16))) unsigned char lds_raw[];
    LAS unsigned char* lds = (LAS unsigned char*)lds_raw;
    const int G = gridDim.x;
    volatile LAS unsigned* misc = (volatile LAS unsigned*)(lds + 131072);
    if (threadIdx.x < 8) misc[threadIdx.x] = 0u;
    __syncthreads();
    const XcdBarrier bar = xcd_barrier_post((unsigned*)(a.ws + WS_CTL), misc);
    for (int ph = a.ph_lo; ph < a.ph_hi; ++ph) {
        if (ph == 0) phase_prologue(a, lds, G);
        else {
            const int l = (ph - 1) / 6, k = (ph - 1) % 6;
            if (k == 0 || k == 4) {
                pg8::Gemm g; pg8::EpiBf16 E; pg8::StaticOrder S;
                if (k == 0) { g = pg8::Gemm{(const bf16*)(a.ws + WS_H), (const bf16*)(a.ws + WS_WIN + l * SZ_WIN1), MMAIN, NPAD, D}; E.O = (bf16*)(a.ws + WS_P); E.ldc = PLD; E.pn_fuse = PN_FUSE; E.rs = (const float*)(a.ws + WS_XN);
                    r_gemm(g.A, g.Bt + (size_t)NPAD * D, E.rs, (float*)(a.ws + WS_R), G, lds);
                    skinny_gemm<4, true>(g.A + (size_t)MMAIN * D, g.Bt, NPAD, E.O + (size_t)MMAIN * PLD, PLD, G, lds, E.rs + MMAIN, (float*)(a.ws + WS_R) + (size_t)MMAIN * 16); }
                else { g = pg8::Gemm{(const bf16*)(a.ws + WS_Y), (const bf16*)(a.ws + WS_WOUT + l * SZ_WOUT1), MMAIN, D, D}; E.O = (bf16*)(a.ws + WS_Z); E.ldc = D; E.pn_fuse = 1 << 30; E.rs = nullptr;
                    skinny_gemm<8, false>(g.A + (size_t)MMAIN * D, g.Bt, D, E.O + (size_t)MMAIN * D, D, G, lds, nullptr, nullptr); }
                S.init(g.M, g.N, G, (int)blockIdx.x);
                pg8::gemm_phase<pg8::EpiBf16, pg8::StaticOrder, true, true>(lds, g, S, E);
            } else if (k == 1) { phase_gla1(a, l, lds, G);
                if (G > 16) { if (blockIdx.x < 8) gla2_items(a, l, lds, (int)blockIdx.x, 8, 8); else phase_conv(a, l, G, 8); }
                else { gla2_items(a, l, lds, (int)blockIdx.x, 8, G); phase_conv(a, l, G, 0); } }
            else if (k == 2) phase_scan(a, G);
            else if (k == 3) phase_gla2(a, l, lds, G);
            else phase_post(a, l, lds, G);
        }
        if (ph + 1 < a.ph_hi) { if (a.ph_hi > NPHASE) cg::this_grid().sync(); else xcd_barrier(bar); }
    }
}

extern "C" void kernel_launch(void* const* d_in, const int* in_sizes, int n_in, void* d_out, int out_size, void* d_ws, size_t ws_size, hipStream_t stream) {
    static int grid = 0;
    if (grid == 0) {
        if (n_in != 10 || ws_size < WS_END) { fprintf(stderr, "kernel_launch: unexpected inputs (n_in %d, ws %zu < %zu)\n", n_in, ws_size, (size_t)WS_END); grid = -1; return; }
        int dev = 0, cus = 0, per_cu = 0;
        hipGetDevice(&dev); hipDeviceGetAttribute(&cus, hipDeviceAttributeMultiprocessorCount, dev);
        if (hipFuncSetAttribute((const void*)hymba_fwd, hipFuncAttributeMaxDynamicSharedMemorySize, LDS_BYTES) != hipSuccess) { fprintf(stderr, "kernel_launch: hipFuncSetAttribute failed\n"); grid = -1; return; }
        hipOccupancyMaxActiveBlocksPerMultiprocessor(&per_cu, (const void*)hymba_fwd, NTHR, LDS_BYTES);
        (void)hipGetLastError();
        if (per_cu < 1) { fprintf(stderr, "kernel_launch: occupancy query says %d blocks per CU\n", per_cu); per_cu = 1; }
        grid = cus;
        if (grid % 8 != 0) { fprintf(stderr, "kernel_launch: %d CUs: the GLA phases need a grid that is a multiple of 8\n", cus); grid = -1; return; }
        if ((MROWS + grid * NWAVES - 1) / (grid * NWAVES) > ROW_ITERS) { fprintf(stderr, "kernel_launch: %d CUs: the row phases are unrolled for >= 229 workgroups\n", cus); grid = -1; return; }
    }
    if (grid < 0) return;
    Args a{};
    a.x = (const float*)d_in[0]; a.meta = (const float*)d_in[1]; a.norm_pre = (const float*)d_in[2]; a.w_in = (const float*)d_in[3];
    a.w_gate_up = (const float*)d_in[4]; a.b_gate = (const float*)d_in[5]; a.gla_norm = (const float*)d_in[6]; a.conv_w = (const float*)d_in[7];
    a.w_out = (const float*)d_in[8]; a.norm_post = (const float*)d_in[9];
    a.out = (float*)d_out; a.ws = (unsigned char*)d_ws;
    (void)hipMemsetAsync((unsigned char*)d_ws + WS_CTL, 0, CTL_BYTES, stream);
#if MK_MULTI
    for (int ph = 0; ph < NPHASE; ++ph) { a.ph_lo = ph; a.ph_hi = ph + 1; hipLaunchKernelGGL(hymba_fwd, dim3(grid), dim3(NTHR), LDS_BYTES, stream, a); }
#else
    a.ph_lo = 0; a.ph_hi = NPHASE;
    void* args[] = {&a};
    hipError_t e = hipLaunchCooperativeKernel((const void*)hymba_fwd, dim3(grid), dim3(NTHR), args, LDS_BYTES, stream);
    if (e != hipSuccess) fprintf(stderr, "cooperative launch failed: %s (grid %d)\n", hipGetErrorString(e), grid);
#endif
}
```

```cpp
#include <hip/hip_runtime.h>
#include <hip/hip_cooperative_groups.h>
#include <cstdio>
#include <cstdint>
namespace cg = cooperative_groups;

#ifndef MK_MULTI
#define MK_MULTI 0
#endif

#define LAS __attribute__((address_space(3)))
typedef unsigned short bf16;
typedef short bf16x8 __attribute__((ext_vector_type(8)));
typedef float f32x4 __attribute__((ext_vector_type(4)));
typedef float f32x16 __attribute__((ext_vector_type(16)));
typedef unsigned u32x4 __attribute__((ext_vector_type(4)));
typedef unsigned u32x2 __attribute__((ext_vector_type(2)));

constexpr int D = 2048, BATCH = 2, SEQ = 8192, DEPTH = 4, NMETA = 16;
constexpr int PADF = 48, LP = 8208, NCH = 129;
constexpr int MROWS = BATCH * LP;
constexpr int MMAIN = 16384;
constexpr int MPAD = MROWS;
constexpr int DPROJ = 7184, NPAD = 7168;
constexpr int PLD = 5120;
constexpr int C_Q = 0, C_K = 512, C_V = 1024, C_ZG = 2048, C_U = 3072, C_G = 4096;
constexpr int PN_FUSE = 12;
constexpr int NSLOT = BATCH * 4 * NCH;
constexpr float EPS = 1e-6f;

constexpr size_t WS_WIN = 0;
constexpr int NWROWS = NPAD + 32;
constexpr size_t SZ_WIN1 = (size_t)NWROWS * D * 2;
constexpr size_t WS_WOUT = WS_WIN + DEPTH * SZ_WIN1;
constexpr size_t SZ_WOUT1 = (size_t)D * D * 2;
constexpr size_t WS_H = WS_WOUT + DEPTH * SZ_WOUT1;
constexpr size_t WS_XN = WS_H + (size_t)MPAD * D * 2;
constexpr size_t WS_P = WS_XN + (size_t)MPAD * D * 2;
constexpr size_t WS_Y = WS_P + (size_t)MPAD * PLD * 2;
constexpr size_t WS_Z = WS_Y + (size_t)MPAD * D * 2;
constexpr size_t WS_ST = WS_Z + (size_t)MPAD * D * 2;
constexpr size_t WS_DEC = WS_ST + (size_t)NSLOT * 32768 * 2;
constexpr size_t WS_R = WS_DEC + (size_t)NSLOT * 128 * 4;
constexpr size_t WS_CTL = WS_R + (size_t)MROWS * 16 * 4;
constexpr size_t CTL_BYTES = 16384;
constexpr size_t WS_END = WS_CTL + CTL_BYTES;

constexpr int NWAVES = 8, NTHR = 512;
constexpr int LDS_BYTES = 131072 + 1024;

typedef float f32x2 __attribute__((ext_vector_type(2)));
typedef __bf16 nbf16x2 __attribute__((ext_vector_type(2)));
__device__ __forceinline__ unsigned pk2(float lo, float hi) { const f32x2 v = {lo, hi}; return __builtin_bit_cast(unsigned, __builtin_convertvector(v, nbf16x2)); }
__device__ __forceinline__ bf16 f2bf(float x) { return (bf16)(pk2(x, 0.f) & 0xffffu); }
__device__ __forceinline__ float bf2f(bf16 u) { return __uint_as_float((unsigned)u << 16); }
__device__ __forceinline__ float bflo(unsigned w) { return __uint_as_float(w << 16); }
__device__ __forceinline__ float bfhi(unsigned w) { return __uint_as_float(w & 0xffff0000u); }
__device__ __forceinline__ float wave_sum(float v) {
#pragma unroll
    for (int o = 1; o < 64; o <<= 1) v += __shfl_xor(v, o);
    return v;
}
__device__ __forceinline__ float silu(float z) { return z * __builtin_amdgcn_rcpf(1.f + __expf(-z)); }
#define LDS_WAIT() asm volatile("s_waitcnt lgkmcnt(0)" ::: "memory")

namespace pg8 {
#define PG8_LAS __attribute__((address_space(3)))
typedef unsigned short bf16_t;
constexpr int BM = 256, BK = 64, HALF = 128, HTB = HALF * BK * 2, STAGE_BYTES = 8 * HTB, NXCD = 8, WGM = 8;

__host__ __device__ __forceinline__ int lds_byte(int r, int c) { const int st = (r >> 4) * 2 + (c >> 5), rr = r & 15, cc = c & 31, ob = rr * 64 + cc * 2; return st * 1024 + (ob ^ (((ob >> 9) & 1) << 5)); }
__host__ __device__ __forceinline__ void stage_rc(int b, int& R, int& C) { const int st = b / 1024, sb = b % 1024, swz = sb ^ (((sb >> 9) & 1) << 5); R = (st >> 1) * 16 + swz / 64; C = (st & 1) * 32 + (swz % 64) / 2; }
__host__ __device__ __forceinline__ int perm32(int rho) { const int n = rho >> 4, i = rho & 15; return 8 * (i >> 2) + 4 * n + (i & 3); }

struct Unit { int pm, pn; };
struct Gemm { const bf16_t* A; const bf16_t* Bt; int M, N, K; };

struct StaticOrder {
    int nM, nN, nwg, G, c;
    __host__ __device__ void init(int M, int N, int G_, int c_) { nM = M / BM; nN = N / BM; nwg = nM * nN; G = G_; c = c_; }
    __host__ __device__ bool next(int i, Unit& u) const {
        const long L = (long)i * G + c; if (L >= nwg) return false;
        int wgid = (int)L; { const int q = nwg / NXCD, r = nwg % NXCD, xcd = wgid % NXCD, off = wgid / NXCD; wgid = (xcd < r ? xcd * (q + 1) : r * (q + 1) + (xcd - r) * q) + off; }
        const int nig = WGM * nN, gid = wgid / nig, fm = gid * WGM, gsz = (nM - fm) < WGM ? (nM - fm) : WGM;
        u.pm = fm + ((wgid % nig) % gsz); u.pn = (wgid % nig) / gsz; return true;
    }
    __device__ __forceinline__ void a_ready(const Unit&) const {}
    __device__ __forceinline__ void done(const Unit&) const {}
};

struct EpiBf16 {
    static constexpr bool PERM = true, AFTER_DRAIN = false;
    bf16_t* O; int ldc; int pn_fuse; const float* rs;
    __device__ __forceinline__ void operator()(const f32x4 (&acc)[2][2][4][2], const Unit& u, int wr, int wc, int fr, int fq) const {
        const int row0 = u.pm * BM + wr * 64 + fr;
        if (u.pn < pn_fuse) {
            const int col0 = u.pn * BM + wc * 32 + 8 * fq;
#pragma unroll
            for (int ai = 0; ai < 2; ++ai)
#pragma unroll
                for (int m = 0; m < 4; ++m) { bf16_t* rowp = O + (size_t)(row0 + ai * HALF + m * 16) * ldc + col0; const float sc = rs ? rs[row0 + ai * HALF + m * 16] : 1.f;
#pragma unroll
                    for (int bj = 0; bj < 2; ++bj) { const f32x4 v0 = acc[ai][bj][m][0] * sc, v1 = acc[ai][bj][m][1] * sc;
                        u32x4 w; w.x = pk2(v0[0], v0[1]); w.y = pk2(v0[2], v0[3]); w.z = pk2(v1[0], v1[1]); w.w = pk2(v1[2], v1[3]);
                        *(u32x4*)(rowp + bj * HALF) = w; } }
        } else {
            const int t = u.pn - pn_fuse; const bool gate = t >= 8;
            const int col0 = pn_fuse * BM + t * HALF + wc * 32 + 8 * fq;
#pragma unroll
            for (int ai = 0; ai < 2; ++ai)
#pragma unroll
                for (int m = 0; m < 4; ++m) { bf16_t* rowp = O + (size_t)(row0 + ai * HALF + m * 16) * ldc + col0; const float sc = rs ? rs[row0 + ai * HALF + m * 16] : 1.f;
                    f32x4 v0 = acc[ai][1][m][0] * sc, v1 = acc[ai][1][m][1] * sc;
                    if (gate) { v0 = (f32x4){silu(v0[0]), silu(v0[1]), silu(v0[2]), silu(v0[3])}; v1 = (f32x4){silu(v1[0]), silu(v1[1]), silu(v1[2]), silu(v1[3])}; }
                    v0 = v0 * (acc[ai][0][m][0] * sc); v1 = v1 * (acc[ai][0][m][1] * sc);
                    u32x4 w; w.x = pk2(v0[0], v0[1]); w.y = pk2(v0[2], v0[3]); w.z = pk2(v1[0], v1[1]); w.w = pk2(v1[2], v1[3]);
                    *(u32x4*)rowp = w; }
        }
    }
};

template <class Epi, class Sched, bool ALIGN_EPI = false, bool SP2 = false>
__device__ __forceinline__ void gemm_phase(PG8_LAS unsigned char* lds, const Gemm g, const Sched& S, const Epi& E) {
    int tid_ = threadIdx.x; asm volatile("" : "+v"(tid_));
    const int tid = tid_, wid = __builtin_amdgcn_readfirstlane(tid >> 6), lane = tid & 63, wr = wid >> 2, wc = wid & 3, fr = lane & 15, fq = lane >> 4;
    const int K = g.K, nt = K / BK;
    unsigned voffA[2], voffB[2];
#pragma unroll
    for (int i = 0; i < 2; ++i) { int R, C; stage_rc(tid * 16 + i * 8192, R, C); const int Rb = Epi::PERM ? ((R & ~31) + perm32(R & 31)) : R;
        voffA[i] = (unsigned)(R * K + C) * 2u; voffB[i] = (unsigned)(Rb * K + C) * 2u; }
    const size_t kstep = (size_t)(BK * 2);
    const size_t hstep = (size_t)HALF * K * 2;
    const size_t tstep = 2 * hstep;
    const unsigned ldsw = (unsigned)wid * 1024u;
    const int aoff = lds_byte(wr * 64 + fr, fq * 8), boff = lds_byte(wc * 32 + fr, fq * 8);
#define PG8_SA(b, h) (((b) * 2 + (h)) * HTB)
#define PG8_SB(b, h) ((4 + (b) * 2 + (h)) * HTB)
#define PG8_STAGE(bufoff, gbase, voff) do { _Pragma("unroll") for (int _i = 0; _i < 2; ++_i) \
        __builtin_amdgcn_global_load_lds((const unsigned*)((const char*)(gbase) + (voff)[_i]), (PG8_LAS unsigned*)(lds + (bufoff) + ldsw + _i * 8192), 16, 0, 0); } while (0)
#define PG8_LDA(dst, b, h) do { _Pragma("unroll") for (int m = 0; m < 4; ++m) _Pragma("unroll") for (int k = 0; k < 2; ++k) dst[m][k] = *(const PG8_LAS bf16x8*)(lds + PG8_SA(b, h) + aoff + m * 2048 + k * 1024); } while (0)
#define PG8_LDB(dst, b, h) do { _Pragma("unroll") for (int n = 0; n < 2; ++n) _Pragma("unroll") for (int k = 0; k < 2; ++k) dst[n][k] = *(const PG8_LAS bf16x8*)(lds + PG8_SB(b, h) + boff + n * 2048 + k * 1024); } while (0)
#define PG8_MMA(ai, bj, At, Bt) do { __builtin_amdgcn_s_setprio(1); _Pragma("unroll") for (int m = 0; m < 4; ++m) _Pragma("unroll") for (int n = 0; n < 2; ++n) _Pragma("unroll") for (int k = 0; k < 2; ++k) \
        acc[ai][bj][m][n] = __builtin_amdgcn_mfma_f32_16x16x32_bf16(Bt[n][k], At[m][k], acc[ai][bj][m][n], 0, 0, 0); __builtin_amdgcn_s_setprio(0); } while (0)
#define PG8_WAIT_V(n) asm volatile("s_waitcnt vmcnt(" #n ")" ::: "memory")
#define PG8_WAIT_L(n) asm volatile("s_waitcnt lgkmcnt(" #n ")" ::: "memory")
#define PG8_BAR __builtin_amdgcn_s_barrier()
#define PG8_SCHED __builtin_amdgcn_sched_barrier(0)
    Unit cur, nxt; int ui = 0;
    if (!S.next(0, cur)) return;
    f32x4 acc[2][2][4][2];
#pragma unroll
    for (int a = 0; a < 2; ++a)
#pragma unroll
        for (int b = 0; b < 2; ++b)
#pragma unroll
            for (int m = 0; m < 4; ++m)
#pragma unroll
                for (int n = 0; n < 2; ++n) acc[a][b][m][n] = (f32x4){0.f, 0.f, 0.f, 0.f};
    bf16x8 At[4][2], B0[2][2], B1[2][2];
    const char* cA = (const char*)g.A + (size_t)cur.pm * tstep; const char* cB = (const char*)g.Bt + (size_t)cur.pn * tstep;
    S.a_ready(cur);
    if constexpr (SP2) {
        PG8_STAGE(PG8_SB(0, 0), cB, voffB); PG8_STAGE(PG8_SB(0, 1), cB + hstep, voffB); PG8_STAGE(PG8_SA(0, 0), cA, voffA); PG8_STAGE(PG8_SA(0, 1), cA + hstep, voffA);
        if (wr == 1) PG8_BAR;
        PG8_WAIT_V(2); PG8_BAR;
        PG8_STAGE(PG8_SB(1, 0), cB + kstep, voffB); PG8_STAGE(PG8_SA(1, 0), cA + kstep, voffA); PG8_STAGE(PG8_SB(1, 1), cB + hstep + kstep, voffB);
        PG8_WAIT_V(6); PG8_BAR;
    } else {
        PG8_STAGE(PG8_SB(0, 0), cB, voffB); PG8_STAGE(PG8_SA(0, 0), cA, voffA); PG8_STAGE(PG8_SB(0, 1), cB + hstep, voffB); PG8_STAGE(PG8_SA(0, 1), cA + hstep, voffA);
        if (wr == 1) PG8_BAR;
        PG8_WAIT_V(4); PG8_BAR;
        PG8_STAGE(PG8_SB(1, 0), cB + kstep, voffB); PG8_STAGE(PG8_SA(1, 0), cA + kstep, voffA); PG8_STAGE(PG8_SB(1, 1), cB + hstep + kstep, voffB);
        PG8_WAIT_V(6); PG8_BAR;
    }
    for (;;) {
        const bool has_next = S.next(ui + 1, nxt);
        const char* nA = has_next ? (const char*)g.A + (size_t)nxt.pm * tstep : cA; const char* nB = has_next ? (const char*)g.Bt + (size_t)nxt.pn * tstep : cB;
        for (int t = 0; t < nt; t += 2) {
            const bool last = (t == nt - 2);
            const char* a1 = cA + (size_t)(t + 1) * kstep;
            const char* a2 = last ? nA : cA + (size_t)(t + 2) * kstep; const char* b2 = last ? nB : cB + (size_t)(t + 2) * kstep;
            const char* a3 = a2 + kstep; const char* b3 = b2 + kstep;
            if (last && has_next) S.a_ready(nxt);
            if constexpr (SP2) {
            PG8_LDB(B0, 0, 0); PG8_LDB(B1, 0, 1); PG8_SCHED; PG8_LDA(At, 0, 0); PG8_STAGE(PG8_SA(1, 1), a1 + hstep, voffA);
            PG8_WAIT_V(8); PG8_WAIT_L(0); PG8_BAR; PG8_MMA(0, 0, At, B0); PG8_MMA(0, 1, At, B1); PG8_BAR; PG8_SCHED;
            PG8_LDA(At, 0, 1); PG8_STAGE(PG8_SB(0, 0), b2, voffB); PG8_STAGE(PG8_SB(0, 1), b2 + hstep, voffB); PG8_STAGE(PG8_SA(0, 0), a2, voffA);
            PG8_WAIT_V(8); PG8_WAIT_L(0); PG8_BAR; PG8_MMA(1, 0, At, B0); PG8_MMA(1, 1, At, B1); PG8_BAR; PG8_SCHED;
            PG8_LDB(B0, 1, 0); PG8_LDB(B1, 1, 1); PG8_SCHED; PG8_LDA(At, 1, 0); PG8_STAGE(PG8_SA(0, 1), a2 + hstep, voffA);
            PG8_WAIT_V(8); PG8_WAIT_L(0); PG8_BAR; PG8_MMA(0, 0, At, B0); PG8_MMA(0, 1, At, B1); PG8_BAR; PG8_SCHED;
            PG8_LDA(At, 1, 1); PG8_STAGE(PG8_SB(1, 0), b3, voffB); PG8_STAGE(PG8_SB(1, 1), b3 + hstep, voffB); PG8_STAGE(PG8_SA(1, 0), a3, voffA);
            PG8_WAIT_V(8); PG8_WAIT_L(0); PG8_BAR; PG8_MMA(1, 0, At, B0); PG8_MMA(1, 1, At, B1); PG8_BAR; PG8_SCHED;
            } else {
            PG8_LDB(B0, 0, 0); PG8_SCHED; PG8_LDA(At, 0, 0); PG8_STAGE(PG8_SA(1, 1), a1 + hstep, voffA);
            PG8_WAIT_L(8); PG8_BAR; PG8_WAIT_L(0); PG8_MMA(0, 0, At, B0); PG8_BAR; PG8_SCHED;
            PG8_LDB(B1, 0, 1); PG8_STAGE(PG8_SB(0, 0), b2, voffB);
            PG8_BAR; PG8_WAIT_L(0); PG8_MMA(0, 1, At, B1); PG8_BAR;
            PG8_LDA(At, 0, 1); PG8_STAGE(PG8_SA(0, 0), a2, voffA);
            PG8_BAR; PG8_WAIT_L(0); PG8_MMA(1, 0, At, B0); PG8_BAR; PG8_SCHED;
            PG8_STAGE(PG8_SB(0, 1), b2 + hstep, voffB);
            PG8_WAIT_V(6); PG8_BAR; PG8_MMA(1, 1, At, B1); PG8_BAR;
            PG8_LDB(B0, 1, 0); PG8_SCHED; PG8_LDA(At, 1, 0); PG8_STAGE(PG8_SA(0, 1), a2 + hstep, voffA);
            PG8_WAIT_L(8); PG8_BAR; PG8_WAIT_L(0); PG8_MMA(0, 0, At, B0); PG8_BAR; PG8_SCHED;
            PG8_LDB(B1, 1, 1); PG8_STAGE(PG8_SB(1, 0), b3, voffB);
            PG8_BAR; PG8_WAIT_L(0); PG8_MMA(0, 1, At, B1); PG8_BAR;
            PG8_LDA(At, 1, 1); PG8_STAGE(PG8_SA(1, 0), a3, voffA);
            PG8_BAR; PG8_WAIT_L(0); PG8_MMA(1, 0, At, B0); PG8_BAR; PG8_SCHED;
            PG8_STAGE(PG8_SB(1, 1), b3 + hstep, voffB);
            PG8_WAIT_V(6); PG8_BAR; PG8_MMA(1, 1, At, B1); PG8_BAR;
            }
        }
        if constexpr (ALIGN_EPI) { if (wr == 0) PG8_BAR; }
        if constexpr (!Epi::AFTER_DRAIN) { E(acc, cur, wr, wc, fr, fq); S.done(cur); }
        if (!has_next) break;
#pragma unroll
        for (int a = 0; a < 2; ++a)
#pragma unroll
            for (int b = 0; b < 2; ++b)
#pragma unroll
                for (int m = 0; m < 4; ++m)
#pragma unroll
                    for (int n = 0; n < 2; ++n) acc[a][b][m][n] = (f32x4){0.f, 0.f, 0.f, 0.f};
        cur = nxt; cA = nA; cB = nB; ++ui;
        if constexpr (ALIGN_EPI) { if (wr == 1) PG8_BAR; }
    }
    PG8_WAIT_V(0);
    if constexpr (!ALIGN_EPI) { if (wr == 0) PG8_BAR; }
    PG8_BAR;
#undef PG8_SA
#undef PG8_SB
#undef PG8_STAGE
#undef PG8_LDA
#undef PG8_LDB
#undef PG8_MMA
#undef PG8_WAIT_V
#undef PG8_WAIT_L
#undef PG8_BAR
#undef PG8_SCHED
}
}

struct Args {
    const float* x; const float* meta; const float* norm_pre; const float* w_in; const float* w_gate_up; const float* b_gate;
    const float* gla_norm; const float* conv_w; const float* w_out; const float* norm_post;
    float* out; unsigned char* ws; int ph_lo, ph_hi;
};

constexpr int T_IIN = (D / 64) * (NPAD / 32), T_IOUT = (D / 64) * (D / 32), T_IL = T_IIN + T_IOUT, T_TOTAL = DEPTH * T_IL;
__device__ __forceinline__ void titem_load(const Args& a, int it, float (&v)[32], int lane) {
    const int l = it / T_IL, r = it % T_IL; const bool win = r < T_IIN; const int item = win ? r : r - T_IIN;
    const int nblk = win ? NPAD / 32 : D / 32, N = win ? DPROJ : D, kb = item / nblk, nb = item % nblk, n0 = 32 * nb;
    const float* W = win ? a.w_in + (size_t)l * D * DPROJ : a.w_out + (size_t)l * D * D;
    int nsrc0 = n0;
    if (win && n0 >= 3072 && n0 < NPAD) { const int q = n0 - 3072, t = q >> 8, half = (q >> 7) & 1, c = q & 127; nsrc0 = (t < 8 ? (half ? 5136 : 3088) + 128 * t : (half ? 6160 : 4112) + 128 * (t - 8)) + c; }
    int ncol = nsrc0 + (lane & 31);
    if (win && n0 >= NPAD) ncol = 3072 + ((lane & 31) < 16 ? (lane & 31) : 15);
    const float* src = W + (size_t)(64 * kb + (lane >> 5)) * N + ncol;
#pragma unroll
    for (int i = 0; i < 32; ++i) v[i] = src[(size_t)(2 * i) * N];
}
__device__ __forceinline__ void titem_store(const Args& a, int it, const float (&v)[32], LAS float* scr, int lane) {
    const int l = it / T_IL, r = it % T_IL; const bool win = r < T_IIN; const int item = win ? r : r - T_IIN;
    const int nblk = win ? NPAD / 32 : D / 32, kb = item / nblk, nb = item % nblk, k0 = 64 * kb, n0 = 32 * nb;
    bf16* WT = win ? (bf16*)(a.ws + WS_WIN + l * SZ_WIN1) : (bf16*)(a.ws + WS_WOUT + l * SZ_WOUT1);
    if (win) { const float* gp = a.norm_pre + (size_t)l * D + k0 + (lane >> 5);
#pragma unroll
        for (int i = 0; i < 32; ++i) scr[(2 * i + (lane >> 5)) * 33 + (lane & 31)] = v[i] * gp[2 * i];
    } else {
#pragma unroll
        for (int i = 0; i < 32; ++i) scr[(2 * i + (lane >> 5)) * 33 + (lane & 31)] = v[i]; }
    LDS_WAIT(); asm volatile("" ::: "memory");
    const int c = lane & 7;
#pragma unroll
    for (int j = 0; j < 4; ++j) { const int nn = (lane >> 3) + 8 * j; const LAS float* sp = scr + (8 * c) * 33 + nn;
        u32x4 o; o.x = pk2(sp[0 * 33], sp[1 * 33]); o.y = pk2(sp[2 * 33], sp[3 * 33]); o.z = pk2(sp[4 * 33], sp[5 * 33]); o.w = pk2(sp[6 * 33], sp[7 * 33]);
        *(u32x4*)(WT + (size_t)(n0 + nn) * D + k0 + 8 * c) = o; }
    LDS_WAIT(); asm volatile("" ::: "memory");
}

constexpr int ROW_ITERS = 9;
static_assert((MROWS + 2047) / 2048 <= ROW_ITERS, "row loop unroll bound");
constexpr int GPOST_OFF = 69632, GPRE_OFF = GPOST_OFF + 8192;
__device__ __forceinline__ void load_gain_lds(LAS unsigned char* lds, int off, const float* g, int tid) { *((LAS f32x4*)(lds + off) + tid) = *((const f32x4*)g + tid); }
__device__ __forceinline__ void xn_tail(const f32x4 (&hv)[8], float s2, bf16* hrow, float* rstd_out, int lane) {
#pragma unroll
    for (int j = 0; j < 4; ++j) { const f32x4 p = hv[2 * j], q = hv[2 * j + 1]; *((u32x4*)hrow + lane + 64 * j) = (u32x4){pk2(p.x, p.y), pk2(p.z, p.w), pk2(q.x, q.y), pk2(q.z, q.w)}; }
    const float rh = rsqrtf(wave_sum(s2) * (1.f / D) + EPS);
    if (lane == 0) *rstd_out = rh;
}

__device__ __forceinline__ void phase_prologue(const Args& a, LAS unsigned char* lds, int G) {
    int tid_ = threadIdx.x; asm volatile("" : "+v"(tid_));
    const int tid = tid_, lane = tid & 63, wave = tid >> 6;
    const int gw = blockIdx.x * NWAVES + wave, NGW = G * NWAVES;
    LAS float* scr = (LAS float*)(lds + wave * 16384);
    {
        float cur[32], nxt[32];
        if (gw < T_TOTAL) titem_load(a, gw, cur, lane);
        for (int it = gw; it < T_TOTAL; it += NGW) {
            const int itn = it + NGW;
            if (itn < T_TOTAL) titem_load(a, itn, nxt, lane);
            titem_store(a, it, cur, scr, lane);
#pragma unroll
            for (int i = 0; i < 32; ++i) cur[i] = nxt[i];
        }
    }
    for (int idx = blockIdx.x * NTHR + tid; idx < DEPTH * 32 * D; idx += G * NTHR) {
        const int l = idx >> 16, e = idx & 65535, j = e >> 11, k = e & 2047;
        const float v = j < 16 ? a.w_in[(size_t)l * D * DPROJ + (size_t)k * DPROJ + 3072 + j] * a.norm_pre[(size_t)l * D + k] : 0.f;
        ((bf16*)(a.ws + WS_WIN + l * SZ_WIN1))[(size_t)(NPAD + j) * D + k] = f2bf(v);
    }
    bf16* H = (bf16*)(a.ws + WS_H); float* RSTD = (float*)(a.ws + WS_XN);
    f32x4 hv[8], hn[8];
    { const int b = gw / LP, tpos = gw % LP; const float* src = tpos < NMETA ? a.meta + (size_t)tpos * D : a.x + ((size_t)b * SEQ + (tpos - NMETA)) * D;
#pragma unroll
      for (int j = 0; j < 8; ++j) hv[j] = *((const f32x4*)src + 2 * (lane + 64 * (j >> 1)) + (j & 1)); }
#pragma unroll
    for (int it_ = 0; it_ < ROW_ITERS; ++it_) { const int m = gw + it_ * NGW; if (m < MROWS) {
        const int mn = m + NGW;
        if (mn < MROWS) { const int b = mn / LP, tpos = mn % LP; const float* src = tpos < NMETA ? a.meta + (size_t)tpos * D : a.x + ((size_t)b * SEQ + (tpos - NMETA)) * D;
#pragma unroll
            for (int j = 0; j < 8; ++j) hn[j] = *((const f32x4*)src + 2 * (lane + 64 * (j >> 1)) + (j & 1)); }
        float s2 = 0.f;
#pragma unroll
        for (int j = 0; j < 8; ++j) s2 += (hv[j].x * hv[j].x + hv[j].y * hv[j].y) + (hv[j].z * hv[j].z + hv[j].w * hv[j].w);
        xn_tail(hv, s2, H + (size_t)m * D, RSTD + m, lane);
#pragma unroll
        for (int j = 0; j < 8; ++j) hv[j] = hn[j];
    } }
}

struct PostRow { u32x4 zr[4]; u32x4 hr[4]; };
__device__ __forceinline__ void post_load(PostRow& p, const bf16* H, const bf16* Z, int m, int lane) {
    const bf16* hrow = H + (size_t)m * D; const bf16* zrow = Z + (size_t)m * D;
#pragma unroll
    for (int j = 0; j < 4; ++j) { p.zr[j] = *((const u32x4*)zrow + lane + 64 * j); p.hr[j] = *((const u32x4*)hrow + lane + 64 * j); }
}
__device__ __forceinline__ void phase_post(const Args& a, int l, LAS unsigned char* lds, int G) {
    int tid_ = threadIdx.x; asm volatile("" : "+v"(tid_));
    const int tid = tid_, lane = tid & 63, wave = tid >> 6;
    const int gw = blockIdx.x * NWAVES + wave, NGW = G * NWAVES;
    bf16* H = (bf16*)(a.ws + WS_H); float* RSTD = (float*)(a.ws + WS_XN); const bf16* Z = (const bf16*)(a.ws + WS_Z);
    const LAS f32x4* gpost = (const LAS f32x4*)(lds + GPOST_OFF);
    const bool lastl = (l == DEPTH - 1);
    PostRow cur, nxt;
    post_load(cur, H, Z, gw, lane);
    load_gain_lds(lds, GPOST_OFF, a.norm_post + (size_t)l * D, tid);
    __syncthreads();
#pragma unroll
    for (int it_ = 0; it_ < ROW_ITERS; ++it_) { const int m = gw + it_ * NGW; if (m < MROWS) {
        const int mn = m + NGW;
        if (mn < MROWS) post_load(nxt, H, Z, mn, lane);
        const int b = m / LP, tpos = m % LP;
        float s = 0.f;
#pragma unroll
        for (int j = 0; j < 4; ++j) { const u32x4 z = cur.zr[j];
            const float a0 = bflo(z.x), a1 = bfhi(z.x), a2 = bflo(z.y), a3 = bfhi(z.y), a4 = bflo(z.z), a5 = bfhi(z.z), a6 = bflo(z.w), a7 = bfhi(z.w);
            s += (a0 * a0 + a1 * a1) + (a2 * a2 + a3 * a3) + (a4 * a4 + a5 * a5) + (a6 * a6 + a7 * a7); }
        const float rz = rsqrtf(wave_sum(s) * (1.f / D) + EPS);
        f32x4 hv[8]; float s2 = 0.f;
#pragma unroll
        for (int j = 0; j < 4; ++j) { const u32x4 hr = cur.hr[j]; hv[2 * j] = (f32x4){bflo(hr.x), bfhi(hr.x), bflo(hr.y), bfhi(hr.y)}; hv[2 * j + 1] = (f32x4){bflo(hr.z), bfhi(hr.z), bflo(hr.w), bfhi(hr.w)}; }
#pragma unroll
        for (int j = 0; j < 4; ++j) { const u32x4 z = cur.zr[j]; const f32x4 g0 = gpost[2 * (lane + 64 * j)], g1 = gpost[2 * (lane + 64 * j) + 1];
            hv[2 * j].x += bflo(z.x) * rz * g0.x; hv[2 * j].y += bfhi(z.x) * rz * g0.y; hv[2 * j].z += bflo(z.y) * rz * g0.z; hv[2 * j].w += bfhi(z.y) * rz * g0.w;
            hv[2 * j + 1].x += bflo(z.z) * rz * g1.x; hv[2 * j + 1].y += bfhi(z.z) * rz * g1.y; hv[2 * j + 1].z += bflo(z.w) * rz * g1.z; hv[2 * j + 1].w += bfhi(z.w) * rz * g1.w;
            s2 += (hv[2 * j].x * hv[2 * j].x + hv[2 * j].y * hv[2 * j].y) + (hv[2 * j].z * hv[2 * j].z + hv[2 * j].w * hv[2 * j].w);
            s2 += (hv[2 * j + 1].x * hv[2 * j + 1].x + hv[2 * j + 1].y * hv[2 * j + 1].y) + (hv[2 * j + 1].z * hv[2 * j + 1].z + hv[2 * j + 1].w * hv[2 * j + 1].w); }
        if (lastl) {
            if (tpos >= NMETA) { float* orow = a.out + ((size_t)b * SEQ + (tpos - NMETA)) * D;
#pragma unroll
                for (int j = 0; j < 8; ++j) { const int e4 = 2 * (lane + 64 * (j >> 1)) + (j & 1); *((f32x4*)orow + e4) = hv[j]; } }
        } else {
            xn_tail(hv, s2, H + (size_t)m * D, RSTD + m, lane);
        }
        if (mn < MROWS) cur = nxt;
    } }
}

__device__ __forceinline__ void r_gemm(const bf16* H, const bf16* WrT, const float* rs, float* R, int G, LAS unsigned char* lds) {
    int tid_ = threadIdx.x; asm volatile("" : "+v"(tid_));
    const int tid = tid_, lane = tid & 63, wave = __builtin_amdgcn_readfirstlane(tid >> 6), fr = lane & 15, fq = lane >> 4;
    constexpr int KS = 2, SLOTS = NWAVES / KS, KSTEPS = (D / 32) / KS, NJOBS = MMAIN / 16, WS_ROW = D + 8;
    const int slot = wave / KS, kpart = wave % KS;
    LAS bf16* wimg = (LAS bf16*)lds; LAS f32x4* part = (LAS f32x4*)(lds + 16 * WS_ROW * 2);
    {
        u32x4 t[8];
#pragma unroll
        for (int i = 0; i < 8; ++i) t[i] = *((const u32x4*)WrT + tid + 512 * i);
#pragma unroll
        for (int i = 0; i < 8; ++i) { const int pc = tid + 512 * i, row = pc >> 8, c8 = pc & 255; *(LAS u32x4*)(wimg + row * WS_ROW + c8 * 8) = t[i]; }
    }
    __syncthreads();
    for (int j0 = 0; j0 < NJOBS; j0 += SLOTS * G) {
        const int job = j0 + slot * G + (int)blockIdx.x; const bool live = job < NJOBS;
        f32x4 acc = (f32x4){0.f, 0.f, 0.f, 0.f};
        if (live) {
            const bf16* ap = H + (size_t)(job * 16 + fr) * D + 8 * fq + kpart * KSTEPS * 32;
            const LAS bf16* bp = wimg + fr * WS_ROW + 8 * fq + kpart * KSTEPS * 32;
#pragma unroll
            for (int kk = 0; kk < KSTEPS; ++kk) { const bf16x8 av = *(const bf16x8*)(ap + 32 * kk), bv = *(const LAS bf16x8*)(bp + 32 * kk); acc = __builtin_amdgcn_mfma_f32_16x16x32_bf16(bv, av, acc, 0, 0, 0); }
            if (kpart != 0) part[wave * 64 + lane] = acc;
        }
        __syncthreads();
        if (live && kpart == 0) { acc += part[(wave + 1) * 64 + lane]; const int m = job * 16 + fr; *(f32x4*)(R + (size_t)m * 16 + 4 * fq) = acc * rs[m]; }
        __syncthreads();
    }
}

template <int KS, bool FUSED>
__device__ __forceinline__ void skinny_gemm(const bf16* A, const bf16* Bt, int N, bf16* O, int ldc, int G, LAS unsigned char* lds, const float* rs, float* Rl) {
    int tid_ = threadIdx.x; asm volatile("" : "+v"(tid_));
    const int tid = tid_, lane = tid & 63, wave = __builtin_amdgcn_readfirstlane(tid >> 6), fr = lane & 15, fq = lane >> 4;
    constexpr int NRG = (MROWS - MMAIN) / 16, NB = FUSED ? 2 : 1, SLOTS = NWAVES / KS, KSTEPS = (D / 32) / KS;
    const int ncg = FUSED ? 96 + 16 * 8 + 1 : N / 16, njobs = NRG * ncg;
    const int slot = wave / KS, kpart = wave % KS;
    LAS f32x4* part = (LAS f32x4*)lds;
    for (int j0 = 0; j0 < njobs; j0 += SLOTS * G) {
        const int job = j0 + slot * G + (int)blockIdx.x; const bool live = job < njobs;
        const int rg = job % NRG, cgp = job / NRG;
        const bool isr = FUSED && cgp == 96 + 16 * 8, fused = FUSED && cgp >= 96 && !isr; const int t = (cgp - 96) >> 3, c16 = (cgp - 96) & 7;
        const int brow0 = FUSED ? (isr ? NPAD : fused ? 3072 + 256 * t + 16 * c16 : 32 * cgp) : 16 * cgp, bstep = fused ? 128 : 16;
        f32x4 acc[NB];
#pragma unroll
        for (int nb = 0; nb < NB; ++nb) acc[nb] = (f32x4){0.f, 0.f, 0.f, 0.f};
        if (live) {
            const bf16* ap = A + (size_t)(rg * 16 + fr) * D + 8 * fq + kpart * KSTEPS * 32;
            const bf16* bp = Bt + (size_t)(brow0 + fr) * D + 8 * fq + kpart * KSTEPS * 32;
#pragma unroll
            for (int kk = 0; kk < KSTEPS; ++kk) { const bf16x8 av = *(const bf16x8*)(ap + 32 * kk);
#pragma unroll
                for (int nb = 0; nb < NB; ++nb) { const bf16x8 bv = *(const bf16x8*)(bp + (size_t)nb * bstep * D + 32 * kk); acc[nb] = __builtin_amdgcn_mfma_f32_16x16x32_bf16(bv, av, acc[nb], 0, 0, 0); } }
            if (kpart != 0) {
#pragma unroll
                for (int nb = 0; nb < NB; ++nb) part[(wave * NB + nb) * 64 + lane] = acc[nb]; }
        }
        __syncthreads();
        if (live && kpart == 0) {
#pragma unroll
            for (int p = 1; p < KS; ++p)
#pragma unroll
                for (int nb = 0; nb < NB; ++nb) acc[nb] += part[((wave + p) * NB + nb) * 64 + lane];
            if (rs) { const float sc = rs[rg * 16 + fr];
#pragma unroll
                for (int nb = 0; nb < NB; ++nb) acc[nb] = acc[nb] * sc; }
            bf16* orow = O + (size_t)(rg * 16 + fr) * ldc + 4 * fq;
            if (isr) *(f32x4*)(Rl + (size_t)(rg * 16 + fr) * 16 + 4 * fq) = acc[0];
            else if (!FUSED) *(u32x2*)(orow + 16 * cgp) = (u32x2){pk2(acc[0][0], acc[0][1]), pk2(acc[0][2], acc[0][3])};
            else if (!fused) {
#pragma unroll
                for (int nb = 0; nb < NB; ++nb) *(u32x2*)(orow + 32 * cgp + nb * 16) = (u32x2){pk2(acc[nb][0], acc[nb][1]), pk2(acc[nb][2], acc[nb][3])};
            } else {
                f32x4 v = acc[NB - 1];
                if (t >= 8) v = (f32x4){silu(v[0]), silu(v[1]), silu(v[2]), silu(v[3])};
                v = v * acc[0];
                *(u32x2*)(orow + C_U + 128 * t + 16 * c16) = (u32x2){pk2(v[0], v[1]), pk2(v[2], v[3])};
            }
        }
        __syncthreads();
    }
}

constexpr int RS_OFF = 0;
constexpr int TOT_OFF = 4096;
constexpr int SC_OFF = 6144;
constexpr int Q1_OFF = 15360;
constexpr int Q2_OFF = Q1_OFF + 17408;
constexpr int K1_OFF = Q2_OFF + 17408;
constexpr int VT_OFF = K1_OFF + 17408;
constexpr int O_OFF = Q1_OFF;
constexpr int QS = 136, VS = 72, OS = 260;

__device__ __forceinline__ int crow(int reg, int h) { return (reg & 3) + 8 * (reg >> 2) + 4 * h; }
#define MFMA32(a, b, c) __builtin_amdgcn_mfma_f32_32x32x16_bf16((a), (b), (c), 0, 0, 0)

__device__ __forceinline__ void gla_decay(LAS unsigned char* lds, const f32x4 rr, const float (&wgr)[16], float bgv, int n, int tid,
                                          float (&bl)[16], float& bmid, float& blast) {
    LAS float* rs = (LAS float*)(lds + RS_OFF); LAS float* tot = (LAS float*)(lds + TOT_OFF);
    const int d = tid & 127, qr = tid >> 7;
    if (tid < 256) *((LAS f32x4*)rs + tid) = rr;
    __syncthreads();
    float acc = 0.f;
#pragma unroll
    for (int ii = 0; ii < 16; ++ii) { const int i = qr * 16 + ii; const LAS f32x4* rp = (const LAS f32x4*)(rs + i * 16);
        const f32x4 r0 = rp[0], r1 = rp[1], r2 = rp[2], r3 = rp[3];
        float x = bgv;
        x += r0.x * wgr[0] + r0.y * wgr[1] + r0.z * wgr[2] + r0.w * wgr[3];
        x += r1.x * wgr[4] + r1.y * wgr[5] + r1.z * wgr[6] + r1.w * wgr[7];
        x += r2.x * wgr[8] + r2.y * wgr[9] + r2.z * wgr[10] + r2.w * wgr[11];
        x += r3.x * wgr[12] + r3.y * wgr[13] + r3.z * wgr[14] + r3.w * wgr[15];
        float la = (fminf(x, 0.f) - __builtin_amdgcn_logf(1.f + __expf(-fabsf(x))) * 0.6931471805599453f) * (1.f / 16.f);
        if (n == 0 && i < PADF) la = 0.f;
        acc += la; bl[ii] = acc; }
    tot[qr * 128 + d] = acc;
    __syncthreads();
    const float t0 = tot[d], t1 = tot[128 + d], t2 = tot[256 + d], t3 = tot[384 + d];
    const float off = (qr > 0 ? t0 : 0.f) + (qr > 1 ? t1 : 0.f) + (qr > 2 ? t2 : 0.f);
#pragma unroll
    for (int ii = 0; ii < 16; ++ii) bl[ii] += off;
    bmid = t0 + t1; blast = (t0 + t1) + (t2 + t3);
}
__device__ __forceinline__ void gate_weights(const Args& a, int l, int h, int d, float (&wgr)[16], float& bgv) {
    const float* wg = a.w_gate_up + (size_t)l * 16 * 512; const float* bg = a.b_gate + (size_t)l * 512;
#pragma unroll
    for (int jj = 0; jj < 16; ++jj) wgr[jj] = wg[jj * 512 + h * 128 + d];
    bgv = bg[h * 128 + d];
}

constexpr int VRP = 544;
__device__ __forceinline__ void vT_load(u32x4 (&raw)[4], const bf16* Prow0, int h, int n, int tid) {
#pragma unroll
    for (int it = 0; it < 4; ++it) { const int pc = tid + 512 * it, row = pc >> 5, ch = pc & 31; raw[it] = *(const u32x4*)(Prow0 + (size_t)row * PLD + C_V + h * 256 + ch * 8);
        if (n == 0 && row < PADF) raw[it] = (u32x4){0u, 0u, 0u, 0u}; }
}
__device__ __forceinline__ void vT_store(LAS unsigned char* lds, const u32x4 (&rawv)[4], int tid) {
#pragma unroll
    for (int it = 0; it < 4; ++it) { const int pc = tid + 512 * it, row = pc >> 5, ch = pc & 31; *(LAS u32x4*)(lds + VT_OFF + row * VRP + ch * 16) = rawv[it]; }
}
typedef short s16x4 __attribute__((ext_vector_type(4)));
__device__ __forceinline__ void vT_frags(bf16x8 (&b)[4], LAS unsigned char* lds, int c, int lane) {
    const int hh = lane >> 5, blk = (lane >> 4) & 1, q = (lane & 15) >> 2, p = lane & 3;
    const unsigned addr = (unsigned)(uintptr_t)(lds + VT_OFF) + (unsigned)((8 * hh + q) * VRP + 16 * (4 * c + 2 * blk + (p >> 1)) + 8 * (p & 1));
    s16x4 r0, r1, r2, r3, r4, r5, r6, r7;
    asm volatile("ds_read_b64_tr_b16 %0, %8\n\tds_read_b64_tr_b16 %1, %8 offset:2176\n\tds_read_b64_tr_b16 %2, %8 offset:8704\n\tds_read_b64_tr_b16 %3, %8 offset:10880\n\t"
                 "ds_read_b64_tr_b16 %4, %8 offset:17408\n\tds_read_b64_tr_b16 %5, %8 offset:19584\n\tds_read_b64_tr_b16 %6, %8 offset:26112\n\tds_read_b64_tr_b16 %7, %8 offset:28288\n\ts_waitcnt lgkmcnt(0)"
                 : "=&v"(r0), "=&v"(r1), "=&v"(r2), "=&v"(r3), "=&v"(r4), "=&v"(r5), "=&v"(r6), "=&v"(r7) : "v"(addr) : "memory");
    b[0] = __builtin_shufflevector(r0, r1, 0, 1, 2, 3, 4, 5, 6, 7); b[1] = __builtin_shufflevector(r2, r3, 0, 1, 2, 3, 4, 5, 6, 7);
    b[2] = __builtin_shufflevector(r4, r5, 0, 1, 2, 3, 4, 5, 6, 7); b[3] = __builtin_shufflevector(r6, r7, 0, 1, 2, 3, 4, 5, 6, 7);
}
static_assert(4 * VRP == 2176 && 16 * VRP == 8704 && 20 * VRP == 10880 && 32 * VRP == 17408 && 36 * VRP == 19584 && 48 * VRP == 26112 && 52 * VRP == 28288, "tr-read offsets");

struct G1Pre { bf16 kraw[16]; u32x4 vraw[4]; f32x4 rr; };
__device__ __forceinline__ void g1_load(G1Pre& p, const Args& a, int item, int tid, int wave, int lane) {
    const int n = item >> 3, bh = item & 7, b = bh >> 2, h = bh & 3, d = tid & 127, qr = tid >> 7;
    const long crow0 = (long)b * LP + n * 64 - PADF;
    const bf16* Prow0 = (const bf16*)(a.ws + WS_P) + crow0 * PLD;
    const bf16* kp = Prow0 + (size_t)(qr * 16) * PLD + C_K + h * 128 + d;
#pragma unroll
    for (int ii = 0; ii < 16; ++ii) { p.kraw[ii] = kp[(size_t)ii * PLD]; if (n == 0 && qr * 16 + ii < PADF) p.kraw[ii] = 0; }
    vT_load(p.vraw, Prow0, h, n, tid);
    p.rr = (f32x4){0.f, 0.f, 0.f, 0.f};
    if (tid < 256) p.rr = *((const f32x4*)((const float*)(a.ws + WS_R) + crow0 * 16) + tid);
}
__device__ __forceinline__ void phase_gla1(const Args& a, int l, LAS unsigned char* lds, int G) {
    int tid_ = threadIdx.x; asm volatile("" : "+v"(tid_));
    const int tid = tid_, lane = tid & 63, wave = __builtin_amdgcn_readfirstlane(tid >> 6), r = lane & 31, hh = lane >> 5;
    bf16* ST = (bf16*)(a.ws + WS_ST); float* DEC = (float*)(a.ws + WS_DEC);
    const int d = tid & 127, qr = tid >> 7;
    constexpr int NITEM = BATCH * 4 * (NCH - 1);
    if ((int)blockIdx.x >= NITEM) return;
    float wgr[16], bgv; gate_weights(a, l, (int)blockIdx.x & 3, d, wgr, bgv);
    G1Pre cur, nxt;
    g1_load(cur, a, (int)blockIdx.x, tid, wave, lane);
    for (int item = blockIdx.x; item < NITEM; item += G) {
        const int n = item >> 3, bh = item & 7, b = bh >> 2, h = bh & 3;
        const int slot = (b * 4 + h) * NCH + n;
        float bl[16], bmid, blast;
        gla_decay(lds, cur.rr, wgr, bgv, n, tid, bl, bmid, blast);
        {
            LAS bf16* kst = (LAS bf16*)(lds + Q1_OFF);
            unsigned pk[8];
#pragma unroll
            for (int ii = 0; ii < 16; ii += 2) { const float k0 = bf2f(cur.kraw[ii]) * __expf(blast - bl[ii]), k1 = bf2f(cur.kraw[ii + 1]) * __expf(blast - bl[ii + 1]); pk[ii >> 1] = pk2(k0, k1); }
            LAS u32x4* dst = (LAS u32x4*)(kst + d * VS + qr * 16);
            dst[0] = (u32x4){pk[0], pk[1], pk[2], pk[3]}; dst[1] = (u32x4){pk[4], pk[5], pk[6], pk[7]};
        }
        vT_store(lds, cur.vraw, tid);
        if (qr == 0) DEC[(size_t)slot * 128 + d] = __expf(blast);
        __syncthreads();
        if (item + G < NITEM) g1_load(nxt, a, item + G, tid, wave, lane);
        f32x16 acc[4];
#pragma unroll
        for (int db = 0; db < 4; ++db)
#pragma unroll
            for (int i = 0; i < 16; ++i) acc[db][i] = 0.f;
        const LAS bf16* kst = (const LAS bf16*)(lds + Q1_OFF);
        bf16x8 vfr[4]; vT_frags(vfr, lds, wave, lane);
#pragma unroll
        for (int s = 0; s < 4; ++s) { const bf16x8 bfr = vfr[s];
#pragma unroll
            for (int db = 0; db < 4; ++db) { const bf16x8 afr = *(const LAS bf16x8*)(kst + (32 * db + r) * VS + 16 * s + 8 * hh); acc[db] = MFMA32(afr, bfr, acc[db]); } }
        bf16* st = ST + (size_t)slot * 32768 + (32 * wave + r) * 128 + 8 * hh;
#pragma unroll
        for (int db = 0; db < 4; ++db)
#pragma unroll
            for (int g = 0; g < 4; g += 2) {
                const unsigned kx = pk2(acc[db][4 * g], acc[db][4 * g + 1]), ky = pk2(acc[db][4 * g + 2], acc[db][4 * g + 3]);
                const unsigned k1x = pk2(acc[db][4 * g + 4], acc[db][4 * g + 5]), k1y = pk2(acc[db][4 * g + 6], acc[db][4 * g + 7]);
                const u32x2 sx = __builtin_amdgcn_permlane32_swap(kx, k1x, false, false), sy = __builtin_amdgcn_permlane32_swap(ky, k1y, false, false);
                *(u32x4*)(st + 32 * db + 8 * g) = (u32x4){sx.x, sy.x, sx.y, sy.y}; }
        __syncthreads();
        cur = nxt;
    }
}

__device__ __forceinline__ void unpack8(const u32x4 v, float (&o)[8]) { o[0] = bflo(v.x); o[1] = bfhi(v.x); o[2] = bflo(v.y); o[3] = bfhi(v.y); o[4] = bflo(v.z); o[5] = bfhi(v.z); o[6] = bflo(v.w); o[7] = bfhi(v.w); }
__device__ __forceinline__ void phase_conv(const Args& a, int l, int G, int cb0) {
    const bf16* P = (const bf16*)(a.ws + WS_P); bf16* Y = (bf16*)(a.ws + WS_Y);
    const float* cw = a.conv_w + (size_t)l * 3 * 1024;
    constexpr int RB = 9, NRB = MROWS / RB;
    const int nthr = (G - cb0) * NTHR;
    int tid_ = threadIdx.x; asm volatile("" : "+v"(tid_));
    for (int idx = ((int)blockIdx.x - cb0) * NTHR + tid_; idx < NRB * 128; idx += nthr) {
        const int rb = idx >> 7, c8 = idx & 127, c0 = c8 * 8;
        const int m0 = rb * RB, tpos0 = m0 % LP;
        bf16* yp = Y + (size_t)m0 * D + 1024 + c0;
        float w0[8], w1[8], w2[8];
#pragma unroll
        for (int t = 0; t < 8; ++t) { w0[t] = cw[c0 + t]; w1[t] = cw[1024 + c0 + t]; w2[t] = cw[2048 + c0 + t]; }
        const bf16* pr = P + (size_t)m0 * PLD + c0;
        u32x4 ur[RB + 2], gr[RB];
        ur[0] = *(const u32x4*)(pr - (size_t)2 * PLD + C_U); ur[1] = *(const u32x4*)(pr - (size_t)PLD + C_U);
#pragma unroll
        for (int i = 0; i < RB; ++i) { ur[2 + i] = *(const u32x4*)(pr + (size_t)i * PLD + C_U); gr[i] = *(const u32x4*)(pr + (size_t)i * PLD + C_G); }
        float um2[8], um1[8];
        unpack8(ur[0], um2); unpack8(ur[1], um1);
        if (tpos0 == 0) {
#pragma unroll
            for (int t = 0; t < 8; ++t) { um1[t] = 0.f; um2[t] = 0.f; } }
#pragma unroll
        for (int i = 0; i < RB; ++i) {
            float u[8], g[8], y[8];
            unpack8(ur[2 + i], u); unpack8(gr[i], g);
#pragma unroll
            for (int t = 0; t < 8; ++t) { y[t] = g[t] * (w0[t] * um2[t] + w1[t] * um1[t] + w2[t] * u[t]); um2[t] = um1[t]; um1[t] = u[t]; }
            u32x4 o; o.x = pk2(y[0], y[1]); o.y = pk2(y[2], y[3]); o.z = pk2(y[4], y[5]); o.w = pk2(y[6], y[7]);
            *(u32x4*)(yp + (size_t)i * D) = o;
        }
    }
}

__device__ __forceinline__ void phase_scan(const Args& a, int G) {
    bf16* ST = (bf16*)(a.ws + WS_ST); const float* DEC = (const float*)(a.ws + WS_DEC);
    const int nthr = G * NTHR;
    int tid_ = threadIdx.x; asm volatile("" : "+v"(tid_));
    for (int idx = blockIdx.x * NTHR + tid_; idx < 8 * 256 * 64; idx += nthr) {
        const int dp = idx & 63, e = (idx >> 6) & 255, bh = idx >> 14;
        unsigned* sp = (unsigned*)(ST + (size_t)bh * NCH * 32768 + e * 128 + 2 * dp);
        const float* dp_ = DEC + (size_t)bh * NCH * 128 + 2 * dp;
        float s0 = 0.f, s1 = 0.f;
        for (int n0 = 0; n0 < NCH - 1; n0 += 8) {
            unsigned u[8]; float a0[8], a1[8];
#pragma unroll
            for (int k = 0; k < 8; ++k) { u[k] = sp[(size_t)(n0 + k) * 16384]; a0[k] = dp_[(n0 + k) * 128]; a1[k] = dp_[(n0 + k) * 128 + 1]; }
#pragma unroll
            for (int k = 0; k < 8; ++k) { sp[(size_t)(n0 + k) * 16384] = pk2(s0, s1); s0 = a0[k] * s0 + bflo(u[k]); s1 = a1[k] * s1 + bfhi(u[k]); }
        }
        sp[(size_t)(NCH - 1) * 16384] = pk2(s0, s1);
    }
}

struct G2Pre { bf16x8 sb[8]; unsigned qk[16]; u32x4 vraw[4], zraw[4]; f32x4 rr; };
__device__ __forceinline__ void g2_load(G2Pre& p, const Args& a, int item, int tid, int wave, int lane) {
    const int n = item >> 3, bh = item & 7, b = bh >> 2, h = bh & 3, d = tid & 127, qr = tid >> 7, r = lane & 31, hh = lane >> 5;
    const int slot = (b * 4 + h) * NCH + n;
    const long crow0 = (long)b * LP + n * 64 - PADF;
    const bf16* Prow0 = (const bf16*)(a.ws + WS_P) + crow0 * PLD;
    if (n != 0) { const bf16* stp = (const bf16*)(a.ws + WS_ST) + (size_t)slot * 32768 + (32 * wave + r) * 128 + 8 * hh;
#pragma unroll
        for (int s = 0; s < 8; ++s) p.sb[s] = *(const bf16x8*)(stp + 16 * s); }
    else {
#pragma unroll
        for (int s = 0; s < 8; ++s) p.sb[s] = (bf16x8){0, 0, 0, 0, 0, 0, 0, 0}; }
    const bf16* qp = Prow0 + (size_t)(qr * 16) * PLD + C_Q + h * 128 + d;
#pragma unroll
    for (int ii = 0; ii < 16; ++ii) { p.qk[ii] = (unsigned)qp[(size_t)ii * PLD] | ((unsigned)qp[(size_t)ii * PLD + C_K] << 16); if (n == 0 && qr * 16 + ii < PADF) p.qk[ii] = 0u; }
    vT_load(p.vraw, Prow0, h, n, tid);
    const bf16* zp = Prow0 + (size_t)(tid >> 3) * PLD + C_ZG + h * 256 + (tid & 7) * 32;
#pragma unroll
    for (int j = 0; j < 4; ++j) p.zraw[j] = *(const u32x4*)(zp + 8 * j);
    p.rr = (f32x4){0.f, 0.f, 0.f, 0.f};
    if (tid < 256) p.rr = *((const f32x4*)((const float*)(a.ws + WS_R) + crow0 * 16) + tid);
}
__device__ __forceinline__ void gla2_items(const Args& a, int l, LAS unsigned char* lds, int item0, int item1, int istride) {
    int tid_ = threadIdx.x; asm volatile("" : "+v"(tid_));
    const int tid = tid_, lane = tid & 63, wave = __builtin_amdgcn_readfirstlane(tid >> 6), r = lane & 31, hh = lane >> 5;
    bf16* Y = (bf16*)(a.ws + WS_Y);
    const float* gno = a.gla_norm + (size_t)l * 256;
    const float qscale = 0.08838834764831845f;
    const int d = tid & 127, qr = tid >> 7;
    if (item0 >= item1) return;
    float wgr[16], bgv; gate_weights(a, l, item0 & 3, d, wgr, bgv);
    G2Pre cur, nxt;
    g2_load(cur, a, item0, tid, wave, lane);
    for (int item = item0; item < item1; item += istride) {
        const int n = item >> 3, bh = item & 7, b = bh >> 2, h = bh & 3;
        const long crow0 = (long)b * LP + n * 64 - PADF;
        float bl[16], bmid, blast;
        gla_decay(lds, cur.rr, wgr, bgv, n, tid, bl, bmid, blast);
        {
            LAS bf16* Q1 = (LAS bf16*)(lds + Q1_OFF); LAS bf16* Q2 = (LAS bf16*)(lds + Q2_OFF); LAS bf16* K1 = (LAS bf16*)(lds + K1_OFF);
            const float embm = __expf(-bmid), ebm = __expf(bmid);
#pragma unroll
            for (int ii = 0; ii < 16; ++ii) { const int i = qr * 16 + ii; const float e2 = __expf(bl[ii]);
                const float q = bflo(cur.qk[ii]) * qscale * e2, k = bfhi(cur.qk[ii]) * ebm * __builtin_amdgcn_rcpf(e2);
                Q2[i * QS + d] = f2bf(q); Q1[i * QS + d] = f2bf(q * embm); K1[i * QS + d] = f2bf(k); }
        }
        vT_store(lds, cur.vraw, tid);
        __syncthreads();
        if (item + istride < item1) g2_load(nxt, a, item + istride, tid, wave, lane);
        const LAS bf16* Q1 = (const LAS bf16*)(lds + Q1_OFF); const LAS bf16* Q2 = (const LAS bf16*)(lds + Q2_OFF); const LAS bf16* K1 = (const LAS bf16*)(lds + K1_OFF);
        LAS bf16* SC = (LAS bf16*)(lds + SC_OFF);
        if (wave < 3) {
            const int jt = wave == 2 ? 1 : 0, it = wave == 0 ? 0 : 1;
            f32x16 sc;
#pragma unroll
            for (int i = 0; i < 16; ++i) sc[i] = 0.f;
#pragma unroll
            for (int s = 0; s < 8; ++s) { const bf16x8 af = *(const LAS bf16x8*)(K1 + (32 * jt + r) * QS + 16 * s + 8 * hh), bf = *(const LAS bf16x8*)(Q1 + (32 * it + r) * QS + 16 * s + 8 * hh); sc = MFMA32(af, bf, sc); }
            const int i = 32 * it + r;
#pragma unroll
            for (int g = 0; g < 4; ++g) { const int j0 = 32 * jt + 8 * g + 4 * hh;
                const float v0 = (j0 + 0 <= i) ? sc[4 * g] : 0.f, v1 = (j0 + 1 <= i) ? sc[4 * g + 1] : 0.f, v2 = (j0 + 2 <= i) ? sc[4 * g + 2] : 0.f, v3 = (j0 + 3 <= i) ? sc[4 * g + 3] : 0.f;
                *(LAS u32x2*)(SC + i * VS + j0) = (u32x2){pk2(v0, v1), pk2(v2, v3)}; }
        }
        f32x16 acc[2];
#pragma unroll
        for (int mi = 0; mi < 2; ++mi)
#pragma unroll
            for (int i = 0; i < 16; ++i) acc[mi][i] = 0.f;
#pragma unroll
        for (int s = 0; s < 8; ++s)
#pragma unroll
            for (int mi = 0; mi < 2; ++mi) { const bf16x8 af = *(const LAS bf16x8*)(Q2 + (32 * mi + r) * QS + 16 * s + 8 * hh); acc[mi] = MFMA32(af, cur.sb[s], acc[mi]); }
        __syncthreads();
        bf16x8 vfr[4]; vT_frags(vfr, lds, wave, lane);
#pragma unroll
        for (int s = 0; s < 4; ++s) { const bf16x8 bf = vfr[s];
            if (s < 2) { const bf16x8 af = *(const LAS bf16x8*)(SC + r * VS + 16 * s + 8 * hh); acc[0] = MFMA32(af, bf, acc[0]); }
            const bf16x8 af1 = *(const LAS bf16x8*)(SC + (32 + r) * VS + 16 * s + 8 * hh); acc[1] = MFMA32(af1, bf, acc[1]); }
        __syncthreads();
        LAS float* O = (LAS float*)(lds + O_OFF);
#pragma unroll
        for (int mi = 0; mi < 2; ++mi)
#pragma unroll
            for (int g = 0; g < 16; ++g) O[(32 * mi + crow(g, hh)) * OS + 32 * wave + r] = acc[mi][g];
        __syncthreads();
        {
            const int i = tid >> 3, seg = tid & 7;
            const LAS f32x4* op = (const LAS f32x4*)(O + i * OS + seg * 32);
            f32x4 o[8]; float s = 0.f;
#pragma unroll
            for (int j = 0; j < 8; ++j) { o[j] = op[j]; s += (o[j].x * o[j].x + o[j].y * o[j].y) + (o[j].z * o[j].z + o[j].w * o[j].w); }
            s += __shfl_xor(s, 1); s += __shfl_xor(s, 2); s += __shfl_xor(s, 4);
            const float rstd = rsqrtf(s * (1.f / 256.f) + EPS);
            bf16* yp = Y + (crow0 + i) * D + h * 256 + seg * 32;
            if (n != 0 || i >= PADF)
#pragma unroll
            for (int j = 0; j < 4; ++j) { const u32x4 z = cur.zraw[j]; const f32x4 g0 = *(const f32x4*)(gno + seg * 32 + 8 * j), g1 = *(const f32x4*)(gno + seg * 32 + 8 * j + 4);
                const f32x4 p = o[2 * j], q = o[2 * j + 1];
                u32x4 w;
                w.x = pk2(p.x * rstd * g0.x * silu(bflo(z.x)), p.y * rstd * g0.y * silu(bfhi(z.x)));
                w.y = pk2(p.z * rstd * g0.z * silu(bflo(z.y)), p.w * rstd * g0.w * silu(bfhi(z.y)));
                w.z = pk2(q.x * rstd * g1.x * silu(bflo(z.z)), q.y * rstd * g1.y * silu(bfhi(z.z)));
                w.w = pk2(q.z * rstd * g1.z * silu(bflo(z.w)), q.w * rstd * g1.w * silu(bfhi(z.w)));
                *(u32x4*)(yp + 8 * j) = w; }
        }
        __syncthreads();
        cur = nxt;
    }
}

__device__ __forceinline__ void phase_gla2(const Args& a, int l, LAS unsigned char* lds, int G) { gla2_items(a, l, lds, 8 + (int)blockIdx.x, BATCH * 4 * NCH, G); }

#define XB_TMO      128
#define XB_XCNT(j)  (256  + 64 * (j))
#define XB_XSUB(j)  (1280 + 64 * (j))
#define XB_XGEN(j)  (2304 + 64 * (j))
#define XB_TOP      3328
#define XB_TOPGEN   3392
#define XCD_BAR_WORDS 3456
#define XB_SPIN_CAP (1u << 18)
__device__ __forceinline__ unsigned xb_ld(unsigned* p)              { return __hip_atomic_load(p, __ATOMIC_RELAXED, __HIP_MEMORY_SCOPE_AGENT); }
__device__ __forceinline__ unsigned xb_add(unsigned* p, unsigned v) { return __hip_atomic_fetch_add(p, v, __ATOMIC_RELAXED, __HIP_MEMORY_SCOPE_AGENT); }
__device__ __forceinline__ unsigned xb_xcc_id() { return (unsigned)__builtin_amdgcn_s_getreg((3 << 11) | 20) & 0xFu; }
#define XB_SPIN(cond, bar) do { unsigned _sp = 0; while (cond) { __builtin_amdgcn_s_sleep(1); \
    if ((++_sp & 255u) == 0u) { if (xb_ld(&(bar)[XB_TMO])) break; if (_sp > XB_SPIN_CAP) { atomicAdd(&(bar)[XB_TMO], 1u); break; } } } } while (0)
struct XcdBarrier { unsigned* bar; unsigned x; volatile LAS unsigned* st; };
__device__ __forceinline__ XcdBarrier xcd_barrier_post(unsigned* bar, volatile LAS unsigned* st) {
    XcdBarrier b; b.bar = bar; b.x = xb_xcc_id(); b.st = st;
    if (threadIdx.x == 0) (void)xb_add(&bar[XB_XCNT(b.x)], 1u);
    return b;
}
__device__ __forceinline__ void xcd_barrier_complete(unsigned* bar, unsigned x, unsigned& nloc, unsigned& nx) {
    const unsigned G = gridDim.x * gridDim.y * gridDim.z;
    unsigned sum, cnt, mine, sp = 0u;
    for (;;) {
        sum = 0u; cnt = 0u; mine = 0u;
#pragma unroll
        for (unsigned j = 0; j < 16; ++j) { const unsigned c = xb_ld(&bar[XB_XCNT(j)]); sum += c; cnt += (c > 0u) ? 1u : 0u; mine = (j == x) ? c : mine; }
        if (sum == G) break;
        __builtin_amdgcn_s_sleep(1);
        if ((++sp & 255u) == 0u) { if (xb_ld(&bar[XB_TMO])) break; if (sp > XB_SPIN_CAP) { atomicAdd(&bar[XB_TMO], 1u); break; } }
    }
    nloc = mine > 0u ? mine : 1u; nx = cnt > 0u ? cnt : 1u;
}
__device__ __forceinline__ void xcd_barrier(const XcdBarrier& b) {
    asm volatile("s_waitcnt vmcnt(0)" ::: "memory");
    __syncthreads();
    if (threadIdx.x == 0) {
        unsigned* bar = b.bar;
        __builtin_amdgcn_s_waitcnt(0);
        unsigned nloc = b.st[0], nx = b.st[1];
        if (nloc == 0u) { xcd_barrier_complete(bar, b.x, nloc, nx); b.st[0] = nloc; b.st[1] = nx; }
        const unsigned old = xb_add(&bar[XB_XSUB(b.x)], 1u);
        const unsigned gen = old / nloc;
        if (old + 1u == (gen + 1u) * nloc) {
            __builtin_amdgcn_fence(__ATOMIC_RELEASE, "agent");
            asm volatile("s_waitcnt vmcnt(0)" ::: "memory");
            const unsigned og = xb_add(&bar[XB_TOP], 1u);
            const unsigned tg = og / nx;
            if (og + 1u == (tg + 1u) * nx) xb_add(&bar[XB_TOPGEN], 1u);
            else XB_SPIN(xb_ld(&bar[XB_TOPGEN]) == tg, bar);
            __builtin_amdgcn_fence(__ATOMIC_ACQUIRE, "agent");
            xb_add(&bar[XB_XGEN(b.x)], 1u);
            asm volatile("s_waitcnt vmcnt(0)" ::: "memory");
        } else {
            XB_SPIN(xb_ld(&bar[XB_XGEN(b.x)]) == gen, bar);
            __builtin_amdgcn_fence(__ATOMIC_ACQUIRE, "agent");
            asm volatile("s_waitcnt vmcnt(0)" ::: "memory");
        }
    }
    __syncthreads();
}

constexpr int NPHASE = 1 + 6 * DEPTH;
__global__ void __launch_bounds__(NTHR, 2) hymba_fwd(Args a) {
    extern __shared__ __attribute__((aligned(16))) unsigned char lds_raw[];
    LAS unsigned char* lds = (LAS unsigned char*)lds_raw;
    const int G = gridDim.x;
    volatile LAS unsigned* misc = (volatile LAS unsigned*)(lds + 131072);
    if (threadIdx.x < 8) misc[threadIdx.x] = 0u;
    __syncthreads();
    const XcdBarrier bar = xcd_barrier_post((unsigned*)(a.ws + WS_CTL), misc);
    for (int ph = a.ph_lo; ph < a.ph_hi; ++ph) {
        if (ph == 0) phase_prologue(a, lds, G);
        else {
            const int l = (ph - 1) / 6, k = (ph - 1) % 6;
            if (k == 0 || k == 4) {
                pg8::Gemm g; pg8::EpiBf16 E; pg8::StaticOrder S;
                if (k == 0) { g = pg8::Gemm{(const bf16*)(a.ws + WS_H), (const bf16*)(a.ws + WS_WIN + l * SZ_WIN1), MMAIN, NPAD, D}; E.O = (bf16*)(a.ws + WS_P); E.ldc = PLD; E.pn_fuse = PN_FUSE; E.rs = (const float*)(a.ws + WS_XN);
                    r_gemm(g.A, g.Bt + (size_t)NPAD * D, E.rs, (float*)(a.ws + WS_R), G, lds);
                    skinny_gemm<4, true>(g.A + (size_t)MMAIN * D, g.Bt, NPAD, E.O + (size_t)MMAIN * PLD, PLD, G, lds, E.rs + MMAIN, (float*)(a.ws + WS_R) + (size_t)MMAIN * 16); }
                else { g = pg8::Gemm{(const bf16*)(a.ws + WS_Y), (const bf16*)(a.ws + WS_WOUT + l * SZ_WOUT1), MMAIN, D, D}; E.O = (bf16*)(a.ws + WS_Z); E.ldc = D; E.pn_fuse = 1 << 30; E.rs = nullptr;
                    skinny_gemm<8, false>(g.A + (size_t)MMAIN * D, g.Bt, D, E.O + (size_t)MMAIN * D, D, G, lds, nullptr, nullptr); }
                S.init(g.M, g.N, G, (int)blockIdx.x);
                pg8::gemm_phase<pg8::EpiBf16, pg8::StaticOrder, true, true>(lds, g, S, E);
            } else if (k == 1) { phase_gla1(a, l, lds, G);
                if (G > 16) { if (blockIdx.x < 8) gla2_items(a, l, lds, (int)blockIdx.x, 8, 8); else phase_conv(a, l, G, 8); }
                else { gla2_items(a, l, lds, (int)blockIdx.x, 8, G); phase_conv(a, l, G, 0); } }
            else if (k == 2) phase_scan(a, G);
            else if (k == 3) phase_gla2(a, l, lds, G);
            else phase_post(a, l, lds, G);
        }
        if (ph + 1 < a.ph_hi) { if (a.ph_hi > NPHASE) cg::this_grid().sync(); else xcd_barrier(bar); }
    }
}

extern "C" void kernel_launch(void* const* d_in, const int* in_sizes, int n_in, void* d_out, int out_size, void* d_ws, size_t ws_size, hipStream_t stream) {
    static int grid = 0;
    if (grid == 0) {
        if (n_in != 10 || ws_size < WS_END) { fprintf(stderr, "kernel_launch: unexpected inputs (n_in %d, ws %zu < %zu)\n", n_in, ws_size, (size_t)WS_END); grid = -1; return; }
        int dev = 0, cus = 0, per_cu = 0;
        hipGetDevice(&dev); hipDeviceGetAttribute(&cus, hipDeviceAttributeMultiprocessorCount, dev);
        if (hipFuncSetAttribute((const void*)hymba_fwd, hipFuncAttributeMaxDynamicSharedMemorySize, LDS_BYTES) != hipSuccess) { fprintf(stderr, "kernel_launch: hipFuncSetAttribute failed\n"); grid = -1; return; }
        hipOccupancyMaxActiveBlocksPerMultiprocessor(&per_cu, (const void*)hymba_fwd, NTHR, LDS_BYTES);
        (void)hipGetLastError();
        if (per_cu < 1) { fprintf(stderr, "kernel_launch: occupancy query says %d blocks per CU\n", per_cu); per_cu = 1; }
        grid = cus;
        if (grid % 8 != 0) { fprintf(stderr, "kernel_launch: %d CUs: the GLA phases need a grid that is a multiple of 8\n", cus); grid = -1; return; }
        if ((MROWS + grid * NWAVES - 1) / (grid * NWAVES) > ROW_ITERS) { fprintf(stderr, "kernel_launch: %d CUs: the row phases are unrolled for >= 229 workgroups\n", cus); grid = -1; return; }
    }
    if (grid < 0) return;
    Args a{};
    a.x = (const float*)d_in[0]; a.meta = (const float*)d_in[1]; a.norm_pre = (const float*)d_in[2]; a.w_in = (const float*)d_in[3];
    a.w_gate_up = (const float*)d_in[4]; a.b_gate = (const float*)d_in[5]; a.gla_norm = (const float*)d_in[6]; a.conv_w = (const float*)d_in[7];
    a.w_out = (const float*)d_in[8]; a.norm_post = (const float*)d_in[9];
    a.out = (float*)d_out; a.ws = (unsigned char*)d_ws;
    (void)hipMemsetAsync((unsigned char*)d_ws + WS_CTL, 0, CTL_BYTES, stream);
#if MK_MULTI
    for (int ph = 0; ph < NPHASE; ++ph) { a.ph_lo = ph; a.ph_hi = ph + 1; hipLaunchKernelGGL(hymba_fwd, dim3(grid), dim3(NTHR), LDS_BYTES, stream, a); }
#else
    a.ph_lo = 0; a.ph_hi = NPHASE;
    void* args[] = {&a};
    hipError_t e = hipLaunchCooperativeKernel((const void*)hymba_fwd, dim3(grid), dim3(NTHR), args, LDS_BYTES, stream);
    if (e != hipSuccess) fprintf(stderr, "cooperative launch failed: %s (grid %d)\n", hipGetErrorString(e), grid);
#endif
}
```
